# Optimizing an MI355X kernel written in HIP

```python
import jax, jax.numpy as jnp
from jax import lax
import numpy as np

D_MODEL = 2048
BATCH = 4
SEQ = 4096
DEPTH = 4

N_MIXERS = 3
EXPAND = 2
D_INNER = EXPAND * D_MODEL
CHUNK = 128
A_GROUPS = 8
A_GROUP_DIM = D_INNER // A_GROUPS
B_GROUPS = 8
B_GROUP_DIM = D_INNER // B_GROUPS
POOL_WINDOWS = (2, 4, 8, 16)
C_GROUPS = len(POOL_WINDOWS)
C_GROUP_DIM = D_INNER // C_GROUPS
EPS = 1e-6

kernel_name = "hybrid_gmlp_fnet_pool_encoder"


def _layers_of_kind(kind):
    return len(range(kind, DEPTH, N_MIXERS))


def rmsnorm(x, g):
    xf = x.astype(jnp.float32)
    y = xf * lax.rsqrt(jnp.mean(xf * xf, axis=-1, keepdims=True) + EPS)
    return (y * g.astype(jnp.float32)).astype(x.dtype)


def gmlp_mixer(h, w_in, v_gain, w_s, b_s):
    bsz, seq, _ = h.shape
    z = h @ w_in
    u, v, gate = jnp.split(z, 3, axis=-1)
    u = jax.nn.gelu(u)
    v = rmsnorm(jax.nn.gelu(v), v_gain)
    vc = v.reshape(bsz, seq // CHUNK, CHUNK, A_GROUPS, A_GROUP_DIM)
    sv = jnp.einsum('gpq,bnqgc->bnpgc', w_s, vc) + b_s.T[None, None, :, :, None]
    y = u * sv.reshape(bsz, seq, D_INNER)
    return y, gate


def fourier_mixer(h, w_in, w_mix):
    bsz, seq, _ = h.shape
    z = h @ w_in
    xb, gate = jnp.split(z, 2, axis=-1)
    xg = xb.reshape(bsz, seq, B_GROUPS, B_GROUP_DIM).astype(jnp.float32)
    f = jnp.fft.fft2(xg, axes=(1, 3), norm="ortho").real.astype(xb.dtype)
    y = jnp.einsum('bsgc,gcd->bsgd', f, w_mix).reshape(bsz, seq, D_INNER)
    return y, gate


def pool_mixer(h, w_in, w_mix, scale):
    bsz, seq, _ = h.shape
    z = h @ w_in
    xc, gate = jnp.split(z, 2, axis=-1)
    xg = xc.reshape(bsz, seq, C_GROUPS, C_GROUP_DIM)
    t = jnp.arange(seq)
    pooled = []
    for gi, w in enumerate(POOL_WINDOWS):
        xi = xg[:, :, gi, :].astype(jnp.float32)
        csum = jnp.pad(lax.cumsum(xi, axis=1), ((0, 0), (1, 0), (0, 0)))
        lo = jnp.clip(t - w // 2, 0, seq - 1)
        hi = jnp.clip(t + w - 1 - w // 2, 0, seq - 1)
        wsum = jnp.take(csum, hi + 1, axis=1) - jnp.take(csum, lo, axis=1)
        cnt = (hi - lo + 1).astype(jnp.float32)[None, :, None]
        pooled.append(wsum / cnt - xi)
    p = jnp.stack(pooled, axis=2).astype(xc.dtype)
    y = jnp.einsum('bsgc,gcd->bsgd', p, w_mix).reshape(bsz, seq, D_INNER) * scale
    return y, gate


def setup_inputs(seed: int = 0) -> dict:
    key = jax.random.key(seed)
    ks = jax.random.split(key, 20)
    na, nb, nc = _layers_of_kind(0), _layers_of_kind(1), _layers_of_kind(2)
    f32 = jnp.float32
    nrm = lambda k, shape, s: jax.random.normal(k, shape, f32) * s
    din = D_MODEL ** -0.5
    dout = D_INNER ** -0.5
    return {
        "x": jax.random.normal(ks[0], (BATCH, SEQ, D_MODEL), f32),
        "a_norm": 1.0 + nrm(ks[1], (na, D_MODEL), 0.05),
        "a_w_in": nrm(ks[2], (na, D_MODEL, 3 * D_INNER), din),
        "a_v_gain": 1.0 + nrm(ks[3], (na, D_INNER), 0.05),
        "a_w_s": nrm(ks[4], (na, A_GROUPS, CHUNK, CHUNK), 0.5 * CHUNK ** -0.5),
        "a_b_s": 1.0 + nrm(ks[5], (na, A_GROUPS, CHUNK), 0.1),
        "a_w_out": nrm(ks[6], (na, D_INNER, D_MODEL), dout),
        "b_norm": 1.0 + nrm(ks[7], (nb, D_MODEL), 0.05),
        "b_w_in": nrm(ks[8], (nb, D_MODEL, 2 * D_INNER), din),
        "b_w_mix": nrm(ks[9], (nb, B_GROUPS, B_GROUP_DIM, B_GROUP_DIM), B_GROUP_DIM ** -0.5),
        "b_w_out": nrm(ks[10], (nb, D_INNER, D_MODEL), dout),
        "c_norm": 1.0 + nrm(ks[11], (nc, D_MODEL), 0.05),
        "c_w_in": nrm(ks[12], (nc, D_MODEL, 2 * D_INNER), din),
        "c_w_mix": nrm(ks[13], (nc, C_GROUPS, C_GROUP_DIM, C_GROUP_DIM), C_GROUP_DIM ** -0.5),
        "c_scale": 1.0 + nrm(ks[14], (nc, D_INNER), 0.1),
        "c_w_out": nrm(ks[15], (nc, D_INNER, D_MODEL), dout),
        "final_norm": 1.0 + nrm(ks[16], (D_MODEL,), 0.05),
    }


def reference(x, a_norm, a_w_in, a_v_gain, a_w_s, a_b_s, a_w_out,
              b_norm, b_w_in, b_w_mix, b_w_out,
              c_norm, c_w_in, c_w_mix, c_scale, c_w_out, final_norm):
    for i in range(DEPTH):
        kind, j = i % N_MIXERS, i // N_MIXERS
        if kind == 0:
            h = rmsnorm(x, a_norm[j])
            y, gate = gmlp_mixer(h, a_w_in[j], a_v_gain[j], a_w_s[j], a_b_s[j])
            w_out = a_w_out[j]
        elif kind == 1:
            h = rmsnorm(x, b_norm[j])
            y, gate = fourier_mixer(h, b_w_in[j], b_w_mix[j])
            w_out = b_w_out[j]
        else:
            h = rmsnorm(x, c_norm[j])
            y, gate = pool_mixer(h, c_w_in[j], c_w_mix[j], c_scale[j])
            w_out = c_w_out[j]
        x = x + (y * jax.nn.silu(gate)) @ w_out
    return rmsnorm(x, final_norm)
```

```cpp
#include <hip/hip_runtime.h>
#include <hip/hip_cooperative_groups.h>
#include <cstdio>
#include <cstdint>
namespace cg = cooperative_groups;

#define LAS __attribute__((address_space(3)))
typedef unsigned short bf16_t;
typedef short bf16x8 __attribute__((ext_vector_type(8)));
typedef float f32x4 __attribute__((ext_vector_type(4)));
typedef unsigned u32x4 __attribute__((ext_vector_type(4)));
typedef unsigned u32x2 __attribute__((ext_vector_type(2)));

constexpr int MTOK = 16384, DM = 2048, DI = 4096, SEQ = 4096;
constexpr float EPS = 1e-6f;
constexpr size_t MiB = (size_t)1 << 20;
constexpr size_t WS_WIN = 0, WS_WOUT = 48 * MiB, WS_WMIX = 64 * MiB, WS_WMTB = 72 * MiB, WS_CS = 76 * MiB, WS_M1 = 77 * MiB, WS_M2 = 78 * MiB;
constexpr size_t WS_RA = 80 * MiB, WS_RB = 208 * MiB, WS_RC = 336 * MiB, WS_RD = 464 * MiB, WS_RE = 592 * MiB, WS_SS = 720 * MiB, WS_BAR = 724 * MiB, WS_END = 725 * MiB;
constexpr int NTHR = 512;
constexpr int LDS_BYTES = 131072;
#ifndef MULTI_LAUNCH
#define MULTI_LAUNCH 0
#endif
#define RUN_B 1
#define RUN_C 1
#define RUN_A2 1
#ifndef DUP_MASK
#define DUP_MASK 0
#endif
#define REP(bit) for (int rep_ = 0; rep_ < (((DUP_MASK) & (bit)) ? 2 : 1); ++rep_)

typedef float f32x2_t __attribute__((ext_vector_type(2)));
typedef __bf16 bf16x2_t __attribute__((ext_vector_type(2)));
__device__ __forceinline__ unsigned cvt_pk_bf16(float lo, float hi) { const f32x2_t v = {lo, hi}; const bf16x2_t r = __builtin_convertvector(v, bf16x2_t); return __builtin_bit_cast(unsigned, r); }
__device__ __forceinline__ float bf_lo(unsigned w) { return __uint_as_float(w << 16); }
__device__ __forceinline__ float bf_hi(unsigned w) { return __uint_as_float(w & 0xffff0000u); }
__device__ __forceinline__ float gelu_t(float x) {
    const float y = x * (1.0f + 0.044715f * x * x);
    const float e = __builtin_amdgcn_exp2f(-2.0f * 0.7978845608f * 1.4426950409f * y);
    return x * __builtin_amdgcn_rcpf(1.0f + e);
}
__device__ __forceinline__ float silu_f(float x) { const float e = __builtin_amdgcn_exp2f(-1.4426950409f * x); return x * __builtin_amdgcn_rcpf(1.0f + e); }
__device__ __forceinline__ f32x2_t ex2_pk(f32x2_t a) { f32x2_t r; r.x = __builtin_amdgcn_exp2f(a.x); r.y = __builtin_amdgcn_exp2f(a.y); return r; }
__device__ __forceinline__ f32x2_t rcp_pk(f32x2_t a) { f32x2_t r; r.x = __builtin_amdgcn_rcpf(a.x); r.y = __builtin_amdgcn_rcpf(a.y); return r; }
__device__ __forceinline__ f32x2_t gelu_pk(f32x2_t v) { const f32x2_t y = v * (v * v * 0.044715f + 1.0f); return v * rcp_pk(ex2_pk(y * (-2.0f * 0.7978845608f * 1.4426950409f)) + 1.0f); }
__device__ __forceinline__ f32x2_t silu_pk(f32x2_t g) { return g * rcp_pk(ex2_pk(g * (-1.4426950409f)) + 1.0f); }
__device__ __forceinline__ f32x2_t gelu_silu_pk(f32x2_t u, f32x2_t g) {
    const f32x2_t y = u * (u * u * 0.044715f + 1.0f);
    const f32x2_t ea = ex2_pk(y * (-2.0f * 0.7978845608f * 1.4426950409f)), eg = ex2_pk(g * (-1.4426950409f));
    return (u * g) * rcp_pk((ea + 1.0f) * (eg + 1.0f));
}

namespace pg8 {
constexpr int BM = 256, BK = 64, HALF = 128, HTB = HALF * BK * 2, STAGE_BYTES = 8 * HTB, NXCD = 8, WGM = 8;
__host__ __device__ __forceinline__ int lds_byte(int r, int c) { const int st = (r >> 4) * 2 + (c >> 5), rr = r & 15, cc = c & 31, ob = rr * 64 + cc * 2; return st * 1024 + (ob ^ (((ob >> 9) & 1) << 5)); }
__host__ __device__ __forceinline__ void stage_rc(int b, int& R, int& C) { const int st = b / 1024, sb = b % 1024, swz = sb ^ (((sb >> 9) & 1) << 5); R = (st >> 1) * 16 + swz / 64; C = (st & 1) * 32 + (swz % 64) / 2; }
__host__ __device__ __forceinline__ int perm32(int rho) { const int n = rho >> 4, i = rho & 15; return 8 * (i >> 2) + 4 * n + (i & 3); }

struct Unit { const char* a; const char* b; int p, pm, pn; };

struct Sched {
    int nM, nN, nwg, G, c, P2;
    const bf16_t* A; const bf16_t* B;
    size_t sA1, sA2, sAm, sB1, sB2, sBn;
    __device__ __forceinline__ bool next(int i, Unit& u) const {
        const long L = (long)i * G + c; if (L >= nwg) return false;
        int wgid = (int)L; { const int q = nwg / NXCD, r = nwg % NXCD, xcd = wgid % NXCD, off = wgid / NXCD; wgid = (xcd < r ? xcd * (q + 1) : r * (q + 1) + (xcd - r) * q) + off; }
        const int per = nM * nN; const int p = wgid / per, w = wgid % per;
        const int nig = WGM * nN, gid = w / nig, fm = gid * WGM, gsz = (nM - fm) < WGM ? (nM - fm) : WGM;
        u.p = p; u.pm = fm + ((w % nig) % gsz); u.pn = (w % nig) / gsz;
        const int p1 = p / P2, p2 = p % P2;
        u.a = (const char*)(A + (size_t)p1 * sA1 + (size_t)p2 * sA2 + (size_t)u.pm * sAm);
        u.b = (const char*)(B + (size_t)p1 * sB1 + (size_t)p2 * sB2 + (size_t)u.pn * sBn);
        return true;
    }
};

template <class Epi>
__device__ __forceinline__ void gemm_phase(LAS unsigned char* lds, const int tid, const int K, const int lda, const int ldb, const Sched& S, const Epi& E) {
    const int wid = __builtin_amdgcn_readfirstlane(tid >> 6), lane = tid & 63, wr = wid >> 2, wc = wid & 3, fr = lane & 15, fq = lane >> 4;
    const int nt = K / BK;
    unsigned voffA[2], voffB[2];
#pragma unroll
    for (int i = 0; i < 2; ++i) { int R, C; stage_rc(tid * 16 + i * 8192, R, C); const int Rb = Epi::PERM ? ((R & ~31) + perm32(R & 31)) : R;
        voffA[i] = (unsigned)(R * lda + C) * 2u; voffB[i] = (unsigned)(Rb * ldb + C) * 2u; }
    const size_t kstep = (size_t)(BK * 2);
    const size_t hstepA = (size_t)HALF * lda * 2, hstepB = (size_t)HALF * ldb * 2;
    const unsigned ldsw = (unsigned)wid * 1024u;
    const int aoff = lds_byte(wr * 64 + fr, fq * 8), boff = lds_byte(wc * 32 + fr, fq * 8);
#define PG8_SA(b, h) (((b) * 2 + (h)) * HTB)
#define PG8_SB(b, h) ((4 + (b) * 2 + (h)) * HTB)
#define PG8_STAGE(bufoff, gbase, voff) do { _Pragma("unroll") for (int _i = 0; _i < 2; ++_i) \
        __builtin_amdgcn_global_load_lds((const unsigned*)((const char*)(gbase) + (voff)[_i]), (LAS unsigned*)(lds + (bufoff) + ldsw + _i * 8192), 16, 0, 0); } while (0)
#define PG8_LDA(dst, b, h) do { _Pragma("unroll") for (int m = 0; m < 4; ++m) _Pragma("unroll") for (int k = 0; k < 2; ++k) dst[m][k] = *(const LAS bf16x8*)(lds + PG8_SA(b, h) + aoff + m * 2048 + k * 1024); } while (0)
#define PG8_LDB(dst, b, h) do { _Pragma("unroll") for (int n = 0; n < 2; ++n) _Pragma("unroll") for (int k = 0; k < 2; ++k) dst[n][k] = *(const LAS bf16x8*)(lds + PG8_SB(b, h) + boff + n * 2048 + k * 1024); } while (0)
#define PG8_MMA(ai, bj, At, Bt) do { __builtin_amdgcn_s_setprio(1); _Pragma("unroll") for (int m = 0; m < 4; ++m) _Pragma("unroll") for (int n = 0; n < 2; ++n) _Pragma("unroll") for (int k = 0; k < 2; ++k) \
        acc[ai][bj][m][n] = __builtin_amdgcn_mfma_f32_16x16x32_bf16(Bt[n][k], At[m][k], acc[ai][bj][m][n], 0, 0, 0); __builtin_amdgcn_s_setprio(0); } while (0)
#define PG8_WAIT_V(n) asm volatile("s_waitcnt vmcnt(" #n ")" ::: "memory")
#define PG8_WAIT_L(n) asm volatile("s_waitcnt lgkmcnt(" #n ")" ::: "memory")
#define PG8_BAR __builtin_amdgcn_s_barrier()
#define PG8_SCHED __builtin_amdgcn_sched_barrier(0)
    Unit cur, nxt; int ui = 0;
    if (!S.next(0, cur)) return;
    f32x4 acc[2][2][4][2];
#pragma unroll
    for (int a = 0; a < 2; ++a)
#pragma unroll
        for (int b = 0; b < 2; ++b)
#pragma unroll
            for (int m = 0; m < 4; ++m)
#pragma unroll
                for (int n = 0; n < 2; ++n) acc[a][b][m][n] = (f32x4){0.f, 0.f, 0.f, 0.f};
    bf16x8 At[4][2], B0[2][2], B1[2][2];
    const char* cA = cur.a; const char* cB = cur.b;
    PG8_STAGE(PG8_SB(0, 0), cB, voffB); PG8_STAGE(PG8_SB(0, 1), cB + hstepB, voffB); PG8_STAGE(PG8_SA(0, 0), cA, voffA); PG8_STAGE(PG8_SA(0, 1), cA + hstepA, voffA);
    if (wr == 1) PG8_BAR;
    PG8_WAIT_V(2); PG8_BAR;
    PG8_STAGE(PG8_SB(1, 0), cB + kstep, voffB); PG8_STAGE(PG8_SA(1, 0), cA + kstep, voffA); PG8_STAGE(PG8_SB(1, 1), cB + hstepB + kstep, voffB);
    PG8_WAIT_V(6); PG8_BAR;
    for (;;) {
        const bool has_next = S.next(ui + 1, nxt);
        const char* nA = has_next ? nxt.a : cA; const char* nB = has_next ? nxt.b : cB;
        for (int t = 0; t < nt; t += 2) {
            const bool last = (t == nt - 2);
            const char* a1 = cA + (size_t)(t + 1) * kstep;
            const char* a2 = last ? nA : cA + (size_t)(t + 2) * kstep; const char* b2 = last ? nB : cB + (size_t)(t + 2) * kstep;
            const char* a3 = a2 + kstep; const char* b3 = b2 + kstep;
            PG8_LDB(B0, 0, 0); PG8_LDB(B1, 0, 1); PG8_SCHED; PG8_LDA(At, 0, 0); PG8_STAGE(PG8_SA(1, 1), a1 + hstepA, voffA);
            PG8_WAIT_V(8); PG8_WAIT_L(0); PG8_BAR; PG8_MMA(0, 0, At, B0); PG8_MMA(0, 1, At, B1); PG8_BAR; PG8_SCHED;
            PG8_LDA(At, 0, 1); PG8_STAGE(PG8_SB(0, 0), b2, voffB); PG8_STAGE(PG8_SB(0, 1), b2 + hstepB, voffB); PG8_STAGE(PG8_SA(0, 0), a2, voffA);
            PG8_WAIT_V(8); PG8_WAIT_L(0); PG8_BAR; PG8_MMA(1, 0, At, B0); PG8_MMA(1, 1, At, B1); PG8_BAR; PG8_SCHED;
            PG8_LDB(B0, 1, 0); PG8_LDB(B1, 1, 1); PG8_SCHED; PG8_LDA(At, 1, 0); PG8_STAGE(PG8_SA(0, 1), a2 + hstepA, voffA);
            PG8_WAIT_V(8); PG8_WAIT_L(0); PG8_BAR; PG8_MMA(0, 0, At, B0); PG8_MMA(0, 1, At, B1); PG8_BAR; PG8_SCHED;
            PG8_LDA(At, 1, 1); PG8_STAGE(PG8_SB(1, 0), b3, voffB); PG8_STAGE(PG8_SB(1, 1), b3 + hstepB, voffB); PG8_STAGE(PG8_SA(1, 0), a3, voffA);
            PG8_WAIT_V(8); PG8_WAIT_L(0); PG8_BAR; PG8_MMA(1, 0, At, B0); PG8_MMA(1, 1, At, B1); PG8_BAR; PG8_SCHED;
        }
        if (wr == 0) PG8_BAR;
        E(acc, cur, wr, wc, fr, fq);
        if (!has_next) break;
#pragma unroll
        for (int a = 0; a < 2; ++a)
#pragma unroll
            for (int b = 0; b < 2; ++b)
#pragma unroll
                for (int m = 0; m < 4; ++m)
#pragma unroll
                    for (int n = 0; n < 2; ++n) acc[a][b][m][n] = (f32x4){0.f, 0.f, 0.f, 0.f};
        cur = nxt; cA = nA; cB = nB; ++ui;
        if (wr == 1) PG8_BAR;
    }
    PG8_WAIT_V(0);
    PG8_BAR;
#undef PG8_SA
#undef PG8_SB
#undef PG8_STAGE
#undef PG8_LDA
#undef PG8_LDB
#undef PG8_MMA
#undef PG8_WAIT_V
#undef PG8_WAIT_L
#undef PG8_BAR
#undef PG8_SCHED
}
}

typedef f32x4 AccT[2][2][4][2];

struct EpiA1 {
    static constexpr bool PERM = true;
    bf16_t* ug; bf16_t* gv; float* sumsq;
    __device__ __forceinline__ void operator()(const AccT& acc, const pg8::Unit& u, int wr, int wc, int fr, int fq) const {
        const int row0 = u.pm * 256 + wr * 64 + fr;
        if (u.pn < 32) {
            const int ch0 = u.pn * 128 + wc * 32 + 8 * fq;
#pragma unroll
            for (int ai = 0; ai < 2; ++ai)
#pragma unroll
                for (int m = 0; m < 4; ++m) {
                    const f32x4 U0 = acc[ai][0][m][0], U1 = acc[ai][0][m][1], G0 = acc[ai][1][m][0], G1 = acc[ai][1][m][1];
                    const f32x2_t r0 = gelu_silu_pk((f32x2_t){U0[0], U0[1]}, (f32x2_t){G0[0], G0[1]}), r1 = gelu_silu_pk((f32x2_t){U0[2], U0[3]}, (f32x2_t){G0[2], G0[3]});
                    const f32x2_t r2 = gelu_silu_pk((f32x2_t){U1[0], U1[1]}, (f32x2_t){G1[0], G1[1]}), r3 = gelu_silu_pk((f32x2_t){U1[2], U1[3]}, (f32x2_t){G1[2], G1[3]});
                    u32x4 w; w.x = cvt_pk_bf16(r0.x, r0.y); w.y = cvt_pk_bf16(r1.x, r1.y); w.z = cvt_pk_bf16(r2.x, r2.y); w.w = cvt_pk_bf16(r3.x, r3.y);
                    __builtin_nontemporal_store(w, (u32x4*)(ug + (size_t)(row0 + ai * 128 + m * 16) * DI + ch0));
                }
        } else {
            const int chb = (u.pn - 32) * 256 + wc * 32 + 8 * fq;
#pragma unroll
            for (int ai = 0; ai < 2; ++ai)
#pragma unroll
                for (int m = 0; m < 4; ++m) {
                    const int row = row0 + ai * 128 + m * 16; float ss = 0.f;
#pragma unroll
                    for (int bj = 0; bj < 2; ++bj) {
                        const f32x4 a0 = acc[ai][bj][m][0], a1 = acc[ai][bj][m][1];
                        const f32x2_t r0 = gelu_pk((f32x2_t){a0[0], a0[1]}), r1 = gelu_pk((f32x2_t){a0[2], a0[3]}), r2 = gelu_pk((f32x2_t){a1[0], a1[1]}), r3 = gelu_pk((f32x2_t){a1[2], a1[3]});
                        const f32x2_t q = (r0 * r0 + r1 * r1) + (r2 * r2 + r3 * r3); ss += q.x + q.y;
                        u32x4 w; w.x = cvt_pk_bf16(r0.x, r0.y); w.y = cvt_pk_bf16(r1.x, r1.y); w.z = cvt_pk_bf16(r2.x, r2.y); w.w = cvt_pk_bf16(r3.x, r3.y);
                        __builtin_nontemporal_store(w, (u32x4*)(gv + (size_t)row * DI + chb + bj * 128));
                    }
                    ss += __shfl_xor(ss, 16); ss += __shfl_xor(ss, 32);
                    if (fq == 0) sumsq[(size_t)((u.pn - 32) * 4 + wc) * MTOK + row] = ss;
                }
        }
    }
};
struct EpiBC1 {
    static constexpr bool PERM = true;
    bf16_t* br; bf16_t* sg;
    __device__ __forceinline__ void operator()(const AccT& acc, const pg8::Unit& u, int wr, int wc, int fr, int fq) const {
        const int row0 = u.pm * 256 + wr * 64 + fr;
        const bool gate = u.pn >= 16;
        bf16_t* dst = gate ? sg : br;
        const int col0 = (gate ? u.pn - 16 : u.pn) * 256 + wc * 32 + 8 * fq;
#pragma unroll
        for (int ai = 0; ai < 2; ++ai)
#pragma unroll
            for (int m = 0; m < 4; ++m)
#pragma unroll
                for (int bj = 0; bj < 2; ++bj) {
                    f32x4 v0 = acc[ai][bj][m][0], v1 = acc[ai][bj][m][1];
                    if (gate) {
                        const f32x2_t r0 = silu_pk((f32x2_t){v0[0], v0[1]}), r1 = silu_pk((f32x2_t){v0[2], v0[3]}), r2 = silu_pk((f32x2_t){v1[0], v1[1]}), r3 = silu_pk((f32x2_t){v1[2], v1[3]});
                        v0 = (f32x4){r0.x, r0.y, r1.x, r1.y}; v1 = (f32x4){r2.x, r2.y, r3.x, r3.y};
                    }
                    u32x4 w; w.x = cvt_pk_bf16(v0[0], v0[1]); w.y = cvt_pk_bf16(v0[2], v0[3]); w.z = cvt_pk_bf16(v1[0], v1[1]); w.w = cvt_pk_bf16(v1[2], v1[3]);
                    __builtin_nontemporal_store(w, (u32x4*)(dst + (size_t)(row0 + ai * 128 + m * 16) * DI + col0 + bj * 128));
                }
    }
};
struct EpiPre {
    static constexpr bool PERM = true;
    bf16_t* bt2;
    __device__ __forceinline__ void operator()(const AccT& acc, const pg8::Unit& u, int wr, int wc, int fr, int fq) const {
        const int g = u.p;
        const int d0 = u.pm * 256 + wr * 64 + fr, c0 = u.pn * 256 + wc * 32 + 8 * fq;
#pragma unroll
        for (int ai = 0; ai < 2; ++ai)
#pragma unroll
            for (int m = 0; m < 4; ++m)
#pragma unroll
                for (int bj = 0; bj < 2; ++bj) {
                    const f32x4 v0 = acc[ai][bj][m][0], v1 = acc[ai][bj][m][1];
                    u32x4 w; w.x = cvt_pk_bf16(v0[0], v0[1]); w.y = cvt_pk_bf16(v0[2], v0[3]); w.z = cvt_pk_bf16(v1[0], v1[1]); w.w = cvt_pk_bf16(v1[2], v1[3]);
                    __builtin_nontemporal_store(w, (u32x4*)(bt2 + ((size_t)(g * 512 + d0 + ai * 128 + m * 16)) * 1024 + c0 + bj * 128));
                }
    }
};
struct EpiW {
    static constexpr bool PERM = true;
    bf16_t* w; const float* cscale;
    __device__ __forceinline__ void operator()(const AccT& acc, const pg8::Unit& u, int wr, int wc, int fr, int fq) const {
        const int row0 = u.p * 1024 + u.pm * 256 + wr * 64 + fr, col0 = u.pn * 256 + wc * 32 + 8 * fq;
#pragma unroll
        for (int ai = 0; ai < 2; ++ai)
#pragma unroll
            for (int m = 0; m < 4; ++m) {
                const int row = row0 + ai * 128 + m * 16; const float sc = cscale[row];
#pragma unroll
                for (int bj = 0; bj < 2; ++bj) {
                    const f32x4 v0 = acc[ai][bj][m][0] * sc, v1 = acc[ai][bj][m][1] * sc;
                    u32x4 q; q.x = cvt_pk_bf16(v0[0], v0[1]); q.y = cvt_pk_bf16(v0[2], v0[3]); q.z = cvt_pk_bf16(v1[0], v1[1]); q.w = cvt_pk_bf16(v1[2], v1[3]);
                    __builtin_nontemporal_store(q, (u32x4*)(w + (size_t)row * DM + col0 + bj * 128));
                }
            }
    }
};
struct EpiGate {
    static constexpr bool PERM = true;
    bf16_t* t; const bf16_t* sg; const float* cscale; float sc; int rowsPerP, colsPerP;
    __device__ __forceinline__ void operator()(const AccT& acc, const pg8::Unit& u, int wr, int wc, int fr, int fq) const {
        const int row0 = u.p * rowsPerP + u.pm * 256 + wr * 64 + fr, col0 = u.p * colsPerP + u.pn * 256 + wc * 32 + 8 * fq;
        u32x4 gq[2][4][2];
#pragma unroll
        for (int ai = 0; ai < 2; ++ai)
#pragma unroll
            for (int m = 0; m < 4; ++m)
#pragma unroll
                for (int bj = 0; bj < 2; ++bj) gq[ai][m][bj] = __builtin_nontemporal_load((const u32x4*)(sg + (size_t)(row0 + ai * 128 + m * 16) * DI + col0 + bj * 128));
        f32x4 s0[2], s1[2];
#pragma unroll
        for (int bj = 0; bj < 2; ++bj) {
            if (cscale) { s0[bj] = *(const f32x4*)(cscale + col0 + bj * 128); s1[bj] = *(const f32x4*)(cscale + col0 + bj * 128 + 4); }
            else { s0[bj] = (f32x4){sc, sc, sc, sc}; s1[bj] = s0[bj]; }
        }
#pragma unroll
        for (int ai = 0; ai < 2; ++ai)
#pragma unroll
            for (int m = 0; m < 4; ++m)
#pragma unroll
                for (int bj = 0; bj < 2; ++bj) {
                    const size_t off = (size_t)(row0 + ai * 128 + m * 16) * DI + col0 + bj * 128;
                    const u32x4 g = gq[ai][m][bj];
                    const f32x4 v0 = acc[ai][bj][m][0] * s0[bj], v1 = acc[ai][bj][m][1] * s1[bj];
                    u32x4 w;
                    w.x = cvt_pk_bf16(v0[0] * bf_lo(g.x), v0[1] * bf_hi(g.x)); w.y = cvt_pk_bf16(v0[2] * bf_lo(g.y), v0[3] * bf_hi(g.y));
                    w.z = cvt_pk_bf16(v1[0] * bf_lo(g.z), v1[1] * bf_hi(g.z)); w.w = cvt_pk_bf16(v1[2] * bf_lo(g.w), v1[3] * bf_hi(g.w));
                    __builtin_nontemporal_store(w, (u32x4*)(t + off));
                }
    }
};
struct EpiOut {
    static constexpr bool PERM = false;
    const float* xold; float* xnew;
    __device__ __forceinline__ void operator()(const AccT& acc, const pg8::Unit& u, int wr, int wc, int fr, int fq) const {
        const int row0 = u.pm * 256 + wr * 64 + fr, col0 = u.pn * 256 + wc * 32 + 4 * fq;
#pragma unroll
        for (int ai = 0; ai < 2; ++ai) {
            f32x4 o[4][2][2];
#pragma unroll
            for (int m = 0; m < 4; ++m)
#pragma unroll
                for (int bj = 0; bj < 2; ++bj)
#pragma unroll
                    for (int n = 0; n < 2; ++n) o[m][bj][n] = __builtin_nontemporal_load((const f32x4*)(xold + (size_t)(row0 + ai * 128 + m * 16) * DM + col0 + bj * 128 + n * 16));
            asm volatile("" ::: "memory");
#pragma unroll
            for (int m = 0; m < 4; ++m)
#pragma unroll
                for (int bj = 0; bj < 2; ++bj)
#pragma unroll
                    for (int n = 0; n < 2; ++n) __builtin_nontemporal_store(o[m][bj][n] + acc[ai][bj][m][n], (f32x4*)(xnew + (size_t)(row0 + ai * 128 + m * 16) * DM + col0 + bj * 128 + n * 16));
            asm volatile("" ::: "memory");
        }
    }
};

struct Ctx { int tid, lane, wave, G, bid; unsigned char* lds; };

__device__ __forceinline__ void conv_tile(const Ctx& C, const float* src, int ldsrc, int k0, int c0, bf16_t* dst, int ldd, int n0) {
    float* T = (float*)C.lds;
    const int kk = C.tid >> 4, c4 = (C.tid & 15) * 4;
#pragma unroll
    for (int i = 0; i < 2; ++i) {
        const int k = kk + 32 * i;
        const f32x4 v = *(const f32x4*)(src + (size_t)(k0 + k) * ldsrc + c0 + c4);
        T[k * 65 + c4 + 0] = v[0]; T[k * 65 + c4 + 1] = v[1]; T[k * 65 + c4 + 2] = v[2]; T[k * 65 + c4 + 3] = v[3];
    }
    __syncthreads();
    const int n = C.tid >> 3, k8 = (C.tid & 7) * 8;
    u32x4 w;
    w.x = cvt_pk_bf16(T[(k8 + 0) * 65 + n], T[(k8 + 1) * 65 + n]); w.y = cvt_pk_bf16(T[(k8 + 2) * 65 + n], T[(k8 + 3) * 65 + n]);
    w.z = cvt_pk_bf16(T[(k8 + 4) * 65 + n], T[(k8 + 5) * 65 + n]); w.w = cvt_pk_bf16(T[(k8 + 6) * 65 + n], T[(k8 + 7) * 65 + n]);
    *(u32x4*)(dst + (size_t)(n0 + n) * ldd + k0 + k8) = w;
    __syncthreads();
}
__device__ __forceinline__ void copy_cvt(const Ctx& C, const float* src, int ldsrc, int rows, int ncols, bf16_t* dst) {
    const int per = ncols / 8, total = rows * per;
    for (int i = C.bid * NTHR + C.tid; i < total; i += C.G * NTHR) {
        const int r = i / per, c = (i % per) * 8;
        const f32x4 a = *(const f32x4*)(src + (size_t)r * ldsrc + c), b = *(const f32x4*)(src + (size_t)r * ldsrc + c + 4);
        u32x4 w; w.x = cvt_pk_bf16(a[0], a[1]); w.y = cvt_pk_bf16(a[2], a[3]); w.z = cvt_pk_bf16(b[0], b[1]); w.w = cvt_pk_bf16(b[2], b[3]);
        *(u32x4*)(dst + (size_t)r * ncols + c) = w;
    }
}
__device__ __forceinline__ void conv_mat(const Ctx& C, const float* src, int ldsrc, int K, int Nd, bf16_t* dst, int mode, int& base) {
    const int tk = K / 64, tn = Nd / 64, ntile = tk * tn;
    int start = (C.bid - (base % C.G) + C.G) % C.G;
    for (int t = start; t < ntile; t += C.G) {
        const int in_ = t / tk, ik = t % tk;
        const int n0 = in_ * 64;
        int c0 = n0;
        if (mode == 1) {
            if (n0 < 8192) { const int tile = n0 >> 8, r = n0 & 255; c0 = (r < 128) ? tile * 128 + r : 8192 + tile * 128 + (r - 128); }
            else c0 = 4096 + (n0 - 8192);
        }
        conv_tile(C, src, ldsrc, ik * 64, c0, dst, K, n0);
    }
    base += ntile;
}
__device__ __forceinline__ void norm_phase(const Ctx& C, const float* x, const float* gain, bf16_t* h) {
    for (int row = C.bid * 8 + C.wave; row < MTOK; row += C.G * 8) {
        const float* xr = x + (size_t)row * DM;
        f32x4 v[8]; float ss = 0.f;
#pragma unroll
        for (int j = 0; j < 4; ++j) {
            v[2 * j] = *(const f32x4*)(xr + (j * 64 + C.lane) * 8); v[2 * j + 1] = *(const f32x4*)(xr + (j * 64 + C.lane) * 8 + 4);
#pragma unroll
            for (int e = 0; e < 4; ++e) ss += v[2 * j][e] * v[2 * j][e] + v[2 * j + 1][e] * v[2 * j + 1][e];
        }
#pragma unroll
        for (int o = 1; o < 64; o <<= 1) ss += __shfl_xor(ss, o);
        const float rs = __builtin_amdgcn_rsqf(ss * (1.0f / DM) + EPS);
#pragma unroll
        for (int j = 0; j < 4; ++j) {
            const int c = (j * 64 + C.lane) * 8;
            const f32x4 g0 = *(const f32x4*)(gain + c), g1 = *(const f32x4*)(gain + c + 4);
            const f32x4 a = v[2 * j] * rs * g0, b = v[2 * j + 1] * rs * g1;
            u32x4 w; w.x = cvt_pk_bf16(a[0], a[1]); w.y = cvt_pk_bf16(a[2], a[3]); w.z = cvt_pk_bf16(b[0], b[1]); w.w = cvt_pk_bf16(b[2], b[3]);
            *(u32x4*)(h + (size_t)row * DM + c) = w;
        }
    }
}
__device__ __forceinline__ void final_norm_phase(const Ctx& C, float* x, const float* gain) {
    for (int row = C.bid * 8 + C.wave; row < MTOK; row += C.G * 8) {
        float* xr = x + (size_t)row * DM;
        f32x4 v[8]; float ss = 0.f;
#pragma unroll
        for (int j = 0; j < 8; ++j) {
            v[j] = *(const f32x4*)(xr + (j * 64 + C.lane) * 4);
#pragma unroll
            for (int e = 0; e < 4; ++e) ss += v[j][e] * v[j][e];
        }
#pragma unroll
        for (int o = 1; o < 64; o <<= 1) ss += __shfl_xor(ss, o);
        const float rs = __builtin_amdgcn_rsqf(ss * (1.0f / DM) + EPS);
#pragma unroll
        for (int j = 0; j < 8; ++j) {
            const int c = (j * 64 + C.lane) * 4;
            const f32x4 g0 = *(const f32x4*)(gain + c);
            *(f32x4*)(xr + c) = v[j] * rs * g0;
        }
    }
}
__device__ __forceinline__ void gen_tables(const Ctx& C, bf16_t* cs, bf16_t* m1, bf16_t* m2) {
    const int gt = C.bid * NTHR + C.tid, GT = C.G * NTHR;
    for (int i = gt; i < 1024 * 512 / 8; i += GT) {
        const int n = i / 64, d0 = (i % 64) * 8; const int c = n & 511; const bool sn = n >= 512;
        float v[8];
#pragma unroll
        for (int e = 0; e < 8; ++e) { const float rev = (float)((c * (d0 + e)) & 511) * (1.0f / 512.0f); v[e] = sn ? __builtin_amdgcn_sinf(rev) : __builtin_amdgcn_cosf(rev); }
        u32x4 w; w.x = cvt_pk_bf16(v[0], v[1]); w.y = cvt_pk_bf16(v[2], v[3]); w.z = cvt_pk_bf16(v[4], v[5]); w.w = cvt_pk_bf16(v[6], v[7]);
        *(u32x4*)(cs + (size_t)i * 8) = w;
    }
    for (int i = gt; i < 64 * 128 * 64 / 8; i += GT) {
        const int s2 = i >> 10, r = (i >> 3) & 127, s10 = (i & 7) * 8; const int k1 = r & 63; const bool sn = r >= 64;
        float v[8];
#pragma unroll
        for (int e = 0; e < 8; ++e) { const float rev = (float)(((64 * (s10 + e) + s2) * k1) & 4095) * (1.0f / 4096.0f); v[e] = sn ? __builtin_amdgcn_sinf(rev) : __builtin_amdgcn_cosf(rev); }
        u32x4 w; w.x = cvt_pk_bf16(v[0], v[1]); w.y = cvt_pk_bf16(v[2], v[3]); w.z = cvt_pk_bf16(v[4], v[5]); w.w = cvt_pk_bf16(v[6], v[7]);
        *(u32x4*)(m1 + (size_t)i * 8) = w;
    }
    for (int i = gt; i < 128 * 128 / 8; i += GT) {
        const int r = i >> 4, c0 = (i & 15) * 8; const int k2 = r & 63; const bool rim = r >= 64;
        float v[8];
#pragma unroll
        for (int e = 0; e < 8; ++e) { const int c = c0 + e, s2 = c & 63; const bool cim = c >= 64; const float rev = (float)((s2 * k2) & 63) * (1.0f / 64.0f);
            const float cs_ = __builtin_amdgcn_cosf(rev), sn_ = __builtin_amdgcn_sinf(rev);
            v[e] = rim ? (cim ? -cs_ : -sn_) : (cim ? -sn_ : cs_); }
        u32x4 w; w.x = cvt_pk_bf16(v[0], v[1]); w.y = cvt_pk_bf16(v[2], v[3]); w.z = cvt_pk_bf16(v[4], v[5]); w.w = cvt_pk_bf16(v[6], v[7]);
        *(u32x4*)(m2 + (size_t)i * 8) = w;
    }
}
typedef short s16x4 __attribute__((ext_vector_type(4)));
constexpr int SK_PITCH = 144, SK_AUX_OFF = 34816, SK_SLAB_OFF = 37376, SK_SLAB_BYTES = 128 * SK_PITCH;
struct SkItem { const bf16_t* in; size_t in_stride; bf16_t* out; const bf16_t* mul; const float* vg; const float* bs; };
template <int MODE> __device__ __forceinline__ size_t sk_out_off(int r) {
    if (MODE == 0) return (size_t)r * DI;
    if (MODE == 1) return (size_t)((r & 63) * 128 + (r >> 6) * 64) * DI;
    return (size_t)(r & 63) * 64 * 8192 + (size_t)(r >> 6) * 512;
}
template <int MODE, int KQ>
__device__ __forceinline__ void sk_core(const Ctx& C, LAS unsigned char* L, const SkItem& it) {
    constexpr int MP = (KQ + 8) * 2;
    const int pair = C.wave >> 1, hw = C.wave & 1, lp = hw * 64 + C.lane;
    const int fr = C.lane & 15, fq = C.lane >> 4, trq = (C.lane & 15) >> 2, trp = C.lane & 3;
    LAS unsigned char* slab = L + SK_SLAB_OFF + pair * SK_SLAB_BYTES;
    __syncthreads();
    {
        u32x4 v[KQ / 16];
#pragma unroll
        for (int i = 0; i < KQ / 16; ++i) v[i] = *(const u32x4*)(it.in + (size_t)((lp >> 3) + 16 * i) * it.in_stride + pair * 64 + (lp & 7) * 8);
#pragma unroll
        for (int i = 0; i < KQ / 16; ++i) *(LAS u32x4*)(slab + ((lp >> 3) + 16 * i) * SK_PITCH + (lp & 7) * 16) = v[i];
    }
    __syncthreads();
    f32x4 acc[4][4];
#pragma unroll
    for (int cb = 0; cb < 4; ++cb)
#pragma unroll
        for (int pb = 0; pb < 4; ++pb) acc[cb][pb] = (f32x4){0.f, 0.f, 0.f, 0.f};
#pragma unroll
    for (int kb = 0; kb < KQ / 32; ++kb) {
        bf16x8 af[4];
#pragma unroll
        for (int cb = 0; cb < 4; ++cb) {
            const s16x4 t0 = __builtin_amdgcn_ds_read_tr16_b64_v4i16((LAS s16x4*)(slab + (32 * kb + 8 * fq + trq) * SK_PITCH + (16 * cb + 4 * trp) * 2));
            const s16x4 t1 = __builtin_amdgcn_ds_read_tr16_b64_v4i16((LAS s16x4*)(slab + (32 * kb + 8 * fq + 4 + trq) * SK_PITCH + (16 * cb + 4 * trp) * 2));
            af[cb] = (bf16x8){t0[0], t0[1], t0[2], t0[3], t1[0], t1[1], t1[2], t1[3]};
        }
#pragma unroll
        for (int pb = 0; pb < 4; ++pb) {
            const bf16x8 bfr = *(const LAS bf16x8*)(L + (64 * hw + pb * 16 + fr) * MP + (kb * 32 + fq * 8) * 2);
#pragma unroll
            for (int cb = 0; cb < 4; ++cb) acc[cb][pb] = __builtin_amdgcn_mfma_f32_16x16x32_bf16(af[cb], bfr, acc[cb][pb], 0, 0, 0);
        }
    }
    __syncthreads();
#pragma unroll
    for (int cb = 0; cb < 4; ++cb) {
        f32x4 vg = (f32x4){1.f, 1.f, 1.f, 1.f};
        if (MODE == 0) vg = *(const f32x4*)(it.vg + pair * 64 + cb * 16 + 4 * fq);
#pragma unroll
        for (int pb = 0; pb < 4; ++pb) {
            const int row = 64 * hw + pb * 16 + fr;
            f32x4 v = acc[cb][pb];
            if (MODE == 0) v = v * vg + it.bs[row];
            u32x2 w; w.x = cvt_pk_bf16(v[0], v[1]); w.y = cvt_pk_bf16(v[2], v[3]);
            *(LAS u32x2*)(slab + row * SK_PITCH + (cb * 16 + 4 * fq) * 2) = w;
        }
    }
    u32x4 mv[8];
    if (MODE == 0) {
#pragma unroll
        for (int i = 0; i < 8; ++i) mv[i] = *(const u32x4*)(it.mul + (size_t)(64 * hw + i * 8 + (C.lane >> 3)) * DI + pair * 64 + (C.lane & 7) * 8);
    }
#pragma unroll
    for (int i = 0; i < 8; ++i) {
        const int row = 64 * hw + i * 8 + (C.lane >> 3);
        u32x4 sv = *(const LAS u32x4*)(slab + row * SK_PITCH + (C.lane & 7) * 16);
        if (MODE == 0) {
            const u32x4 m = mv[i];
            sv.x = cvt_pk_bf16(bf_lo(sv.x) * bf_lo(m.x), bf_hi(sv.x) * bf_hi(m.x)); sv.y = cvt_pk_bf16(bf_lo(sv.y) * bf_lo(m.y), bf_hi(sv.y) * bf_hi(m.y));
            sv.z = cvt_pk_bf16(bf_lo(sv.z) * bf_lo(m.z), bf_hi(sv.z) * bf_hi(m.z)); sv.w = cvt_pk_bf16(bf_lo(sv.w) * bf_lo(m.w), bf_hi(sv.w) * bf_hi(m.w));
        }
        *(u32x4*)(it.out + sk_out_off<MODE>(row) + pair * 64 + (C.lane & 7) * 8) = sv;
    }
}
__device__ __forceinline__ void mixA_phase(const Ctx& C, const bf16_t* ug, const bf16_t* gv, const float* sumsq, const float* w_s, const float* b_s, const float* v_gain, bf16_t* t) {
    constexpr int WP = 136;
    LAS unsigned char* L = (LAS unsigned char*)C.lds;
    float* rstd = (float*)(C.lds + SK_AUX_OFF);
    float* red = (float*)(C.lds + SK_AUX_OFF + 512);
    bf16_t* Wl = (bf16_t*)C.lds;
    for (int item = C.bid; item < 1024; item += C.G) {
        const int g = item & 7, n = item >> 3;
        __syncthreads();
        {
            const int r = C.tid & 127, part = C.tid >> 7; float a = 0.f;
#pragma unroll
            for (int i = 0; i < 16; ++i) a += sumsq[(size_t)(part * 16 + i) * MTOK + n * 128 + r];
            red[part * 128 + r] = a;
            __syncthreads();
            if (C.tid < 128) rstd[C.tid] = __builtin_amdgcn_rsqf(((red[C.tid] + red[128 + C.tid]) + (red[256 + C.tid] + red[384 + C.tid])) * (1.0f / DI) + EPS);
        }
        __syncthreads();
        {
            const int p = C.tid >> 2, q0 = (C.tid & 3) * 32;
            const float* wsrc = w_s + ((size_t)g * 128 + p) * 128 + q0;
#pragma unroll
            for (int j = 0; j < 4; ++j) {
                const f32x4 a = *(const f32x4*)(wsrc + j * 8), b = *(const f32x4*)(wsrc + j * 8 + 4);
                const int q = q0 + j * 8;
                u32x4 w;
                w.x = cvt_pk_bf16(a[0] * rstd[q + 0], a[1] * rstd[q + 1]); w.y = cvt_pk_bf16(a[2] * rstd[q + 2], a[3] * rstd[q + 3]);
                w.z = cvt_pk_bf16(b[0] * rstd[q + 4], b[1] * rstd[q + 5]); w.w = cvt_pk_bf16(b[2] * rstd[q + 6], b[3] * rstd[q + 7]);
                *(u32x4*)(Wl + p * WP + q) = w;
            }
        }
        const size_t off0 = (size_t)n * 128 * DI + g * 512;
#pragma unroll 1
        for (int h = 0; h < 2; ++h) {
            SkItem it{gv + off0 + h * 256, (size_t)DI, t + off0 + h * 256, ug + off0 + h * 256, v_gain + g * 512 + h * 256, b_s + g * 128};
            sk_core<0, 128>(C, L, it);
        }
    }
}
__device__ __forceinline__ void fft1_phase(const Ctx& C, const bf16_t* xb, const bf16_t* m1, bf16_t* ap) {
    LAS unsigned char* L = (LAS unsigned char*)C.lds;
    for (int w = C.bid; w < 256; w += C.G) {
        const int s2 = w >> 2, sub = w & 3;
        __syncthreads();
#pragma unroll
        for (int i = 0; i < 2; ++i) { const int idx = C.tid * 8 + i * 4096, r = idx >> 6, c = idx & 63;
            *(LAS u32x4*)(L + r * 144 + c * 2) = *(const u32x4*)(m1 + (size_t)s2 * 8192 + idx); }
#pragma unroll 1
        for (int j = 0; j < 16; ++j) {
            const int combo = sub * 16 + j, b = combo >> 4, cblk = combo & 15;
            SkItem it{xb + (size_t)(b * SEQ + s2) * DI + cblk * 256, (size_t)64 * DI, ap + ((size_t)(b * 64) * 128 + s2) * DI + cblk * 256, nullptr, nullptr, nullptr};
            sk_core<1, 64>(C, L, it);
        }
    }
}
__device__ __forceinline__ void fft2_phase(const Ctx& C, const bf16_t* ap, const bf16_t* m2, bf16_t* cs) {
    LAS unsigned char* L = (LAS unsigned char*)C.lds;
    __syncthreads();
#pragma unroll
    for (int i = 0; i < 4; ++i) { const int idx = C.tid * 8 + i * 4096, r = idx >> 7, c = idx & 127;
        *(LAS u32x4*)(L + r * 272 + c * 2) = *(const u32x4*)(m2 + idx); }
#pragma unroll 1
    for (int item = C.bid; item < 4096; item += C.G) {
        const int cblk = item & 15, k1 = (item >> 4) & 63, b = item >> 10;
        SkItem it{ap + ((size_t)(b * 64 + k1) * 128) * DI + cblk * 256, (size_t)DI, cs + (size_t)(b * SEQ + k1) * 8192 + (cblk >> 1) * 1024 + (cblk & 1) * 256, nullptr, nullptr, nullptr};
        sk_core<2, 128>(C, L, it);
    }
}
template <int W>
__device__ __forceinline__ void pool_rows(const bf16_t* xc, const bf16_t* sg, bf16_t* p, int tok0, int ntok, int c8) {
    constexpr int LO = W / 2, TPI = 16 / W;
    for (int t0 = 0; t0 < ntok; t0 += TPI) {
        u32x4 q[TPI][W], gq[TPI];
#pragma unroll
        for (int tt = 0; tt < TPI; ++tt) {
            const int tok = tok0 + t0 + tt, spos = tok & (SEQ - 1), base = tok - spos;
            gq[tt] = *(const u32x4*)(sg + (size_t)tok * DI + c8);
#pragma unroll
            for (int j = 0; j < W; ++j) { int r = spos - LO + j; r = r < 0 ? 0 : (r > SEQ - 1 ? SEQ - 1 : r); q[tt][j] = *(const u32x4*)(xc + (size_t)(base + r) * DI + c8); }
        }
#pragma unroll
        for (int tt = 0; tt < TPI; ++tt) {
            const int tok = tok0 + t0 + tt, spos = tok & (SEQ - 1);
            float s[8] = {0.f, 0.f, 0.f, 0.f, 0.f, 0.f, 0.f, 0.f}; int cnt = 0;
#pragma unroll
            for (int j = 0; j < W; ++j) {
                const int r = spos - LO + j; const bool ok = (r >= 0) && (r <= SEQ - 1); const float f = ok ? 1.f : 0.f; cnt += ok ? 1 : 0;
                const u32x4 v = q[tt][j];
                s[0] += f * bf_lo(v.x); s[1] += f * bf_hi(v.x); s[2] += f * bf_lo(v.y); s[3] += f * bf_hi(v.y);
                s[4] += f * bf_lo(v.z); s[5] += f * bf_hi(v.z); s[6] += f * bf_lo(v.w); s[7] += f * bf_hi(v.w);
            }
            const float ic = 1.0f / (float)cnt; const u32x4 me = q[tt][LO]; const u32x4 g = gq[tt];
            u32x4 o;
            o.x = cvt_pk_bf16((s[0] * ic - bf_lo(me.x)) * bf_lo(g.x), (s[1] * ic - bf_hi(me.x)) * bf_hi(g.x)); o.y = cvt_pk_bf16((s[2] * ic - bf_lo(me.y)) * bf_lo(g.y), (s[3] * ic - bf_hi(me.y)) * bf_hi(g.y));
            o.z = cvt_pk_bf16((s[4] * ic - bf_lo(me.z)) * bf_lo(g.z), (s[5] * ic - bf_hi(me.z)) * bf_hi(g.z)); o.w = cvt_pk_bf16((s[6] * ic - bf_lo(me.w)) * bf_lo(g.w), (s[7] * ic - bf_hi(me.w)) * bf_hi(g.w));
            *(u32x4*)(p + (size_t)tok * DI + c8) = o;
        }
    }
}
__device__ __forceinline__ void pool_phase(const Ctx& C, const bf16_t* xc, const bf16_t* sg, bf16_t* p) {
    const int c8 = C.tid * 8; const int grp = C.wave >> 1;
    for (int blk = C.bid; blk < MTOK / 64; blk += C.G) {
        if (grp == 0) pool_rows<2>(xc, sg, p, blk * 64, 64, c8);
        else if (grp == 1) pool_rows<4>(xc, sg, p, blk * 64, 64, c8);
        else if (grp == 2) pool_rows<8>(xc, sg, p, blk * 64, 64, c8);
        else pool_rows<16>(xc, sg, p, blk * 64, 64, c8);
    }
}

__device__ __forceinline__ void grid_bar(unsigned* base, unsigned gen, unsigned G) {
    asm volatile("s_waitcnt vmcnt(0) lgkmcnt(0)" ::: "memory");
    __syncthreads();
    if (threadIdx.x == 0) {
        __builtin_amdgcn_fence(__ATOMIC_RELEASE, "agent");
        asm volatile("s_waitcnt vmcnt(0)" ::: "memory");
        unsigned* flag = base + 64 * (1 + (blockIdx.x >> 4));
        (void)__hip_atomic_fetch_add(base, 1u, __ATOMIC_RELAXED, __HIP_MEMORY_SCOPE_AGENT);
        if ((blockIdx.x & 15u) == 0u) {
            while (__hip_atomic_load(base, __ATOMIC_RELAXED, __HIP_MEMORY_SCOPE_AGENT) < gen * G) __builtin_amdgcn_s_sleep(1);
            __hip_atomic_store(flag, gen, __ATOMIC_RELAXED, __HIP_MEMORY_SCOPE_AGENT);
        } else {
            while (__hip_atomic_load(flag, __ATOMIC_RELAXED, __HIP_MEMORY_SCOPE_AGENT) < gen) __builtin_amdgcn_s_sleep(1);
        }
        __builtin_amdgcn_fence(__ATOMIC_ACQUIRE, "agent");
        asm volatile("s_waitcnt vmcnt(0)" ::: "memory");
    }
    __syncthreads();
}

struct Args { const float* in[17]; float* out; unsigned char* ws; int ph_lo, ph_hi; };

#define PHASE_BEGIN if (ph >= lo && ph < hi) { \
        unsigned char* ws = args.ws; asm volatile("" : "+s"(ws)); int tid_ = threadIdx.x; asm volatile("" : "+v"(tid_)); \
        Ctx C; C.tid = tid_; C.lane = tid_ & 63; C.wave = __builtin_amdgcn_readfirstlane(tid_ >> 6); C.G = gridDim.x; C.bid = blockIdx.x; C.lds = lds_raw; \
        LAS unsigned char* ldsl = (LAS unsigned char*)lds_raw; (void)ldsl; (void)ws;
#define PHASE_END   if (ph + 1 < hi) { if (ph == 0) grid.sync(); else { ++nbar; grid_bar((unsigned*)(args.ws + WS_BAR), nbar, gridDim.x); } } } ++ph;
#define WSP(T, off) ((T*)(ws + (off)))

#define GEMM_OUT(TBUF, XCUR) PHASE_BEGIN { \
        pg8::Sched S{64, 8, 64 * 8, C.G, C.bid, 1, WSP(bf16_t, TBUF), WSP(bf16_t, WS_WOUT), 0, 0, (size_t)256 * DI, 0, 0, (size_t)256 * DI}; \
        EpiOut E{XCUR, args.out}; \
        pg8::gemm_phase<EpiOut>(ldsl, C.tid, DI, DI, DI, S, E); } PHASE_END

#define LAYER_A(J, XCUR, FIRST) \
    PHASE_BEGIN REP(2) { int base = 0; \
        conv_mat(C, args.in[2] + (size_t)(J) * DM * 3 * DI, 3 * DI, DM, 3 * DI, WSP(bf16_t, WS_WIN), 1, base); \
        conv_mat(C, args.in[6] + (size_t)(J) * DI * DM, DM, DI, DM, WSP(bf16_t, WS_WOUT), 0, base); \
        if (FIRST) gen_tables(C, WSP(bf16_t, WS_CS), WSP(bf16_t, WS_M1), WSP(bf16_t, WS_M2)); \
        norm_phase(C, XCUR, args.in[1] + (size_t)(J) * DM, WSP(bf16_t, WS_RB)); } PHASE_END \
    PHASE_BEGIN REP(8) { \
        pg8::Sched S{64, 48, 64 * 48, C.G, C.bid, 1, WSP(bf16_t, WS_RB), WSP(bf16_t, WS_WIN), 0, 0, (size_t)256 * DM, 0, 0, (size_t)256 * DM}; \
        EpiA1 E{WSP(bf16_t, WS_RC), WSP(bf16_t, WS_RD), WSP(float, WS_SS)}; \
        pg8::gemm_phase<EpiA1>(ldsl, C.tid, DM, DM, DM, S, E); } PHASE_END \
    PHASE_BEGIN REP(1) { \
        mixA_phase(C, WSP(bf16_t, WS_RC), WSP(bf16_t, WS_RD), WSP(float, WS_SS), args.in[4] + (size_t)(J) * 8 * 128 * 128, args.in[5] + (size_t)(J) * 8 * 128, args.in[3] + (size_t)(J) * DI, WSP(bf16_t, WS_RE)); } PHASE_END \
    GEMM_OUT(WS_RE, XCUR)

#define LAYER_B(XCUR) \
    PHASE_BEGIN REP(2) { int base = 0; \
        conv_mat(C, args.in[8], 2 * DI, DM, 2 * DI, WSP(bf16_t, WS_WIN), 0, base); \
        conv_mat(C, args.in[10], DM, DI, DM, WSP(bf16_t, WS_WOUT), 0, base); \
        for (int g = 0; g < 8; ++g) conv_mat(C, args.in[9] + (size_t)g * 512 * 512, 512, 512, 512, WSP(bf16_t, WS_WMTB) + (size_t)g * 512 * 512, 0, base); \
        norm_phase(C, XCUR, args.in[7], WSP(bf16_t, WS_RB)); } PHASE_END \
    PHASE_BEGIN { \
        pg8::Sched S{2, 4, 8 * 2 * 4, C.G, C.bid, 1, WSP(bf16_t, WS_WMTB), WSP(bf16_t, WS_CS), (size_t)512 * 512, 0, (size_t)256 * 512, 0, 0, (size_t)256 * 512}; \
        EpiPre E{WSP(bf16_t, WS_WMIX)}; \
        pg8::gemm_phase<EpiPre>(ldsl, C.tid, 512, 512, 512, S, E); } \
        if (ph + 1 < hi) {   } } ++ph; \
    PHASE_BEGIN { \
        pg8::Sched S{64, 32, 64 * 32, C.G, C.bid, 1, WSP(bf16_t, WS_RB), WSP(bf16_t, WS_WIN), 0, 0, (size_t)256 * DM, 0, 0, (size_t)256 * DM}; \
        EpiBC1 E{WSP(bf16_t, WS_RC), WSP(bf16_t, WS_RA)}; \
        pg8::gemm_phase<EpiBC1>(ldsl, C.tid, DM, DM, DM, S, E); } PHASE_END \
    PHASE_BEGIN REP(4) { fft1_phase(C, WSP(bf16_t, WS_RC), WSP(bf16_t, WS_M1), WSP(bf16_t, WS_RD)); } PHASE_END \
    PHASE_BEGIN REP(4) { fft2_phase(C, WSP(bf16_t, WS_RD), WSP(bf16_t, WS_M2), WSP(bf16_t, WS_RB)); } PHASE_END \
    PHASE_BEGIN REP(32) { \
        pg8::Sched S{64, 2, 8 * 64 * 2, C.G, C.bid, 1, WSP(bf16_t, WS_RB), WSP(bf16_t, WS_WMIX), 1024, 0, (size_t)256 * 8192, (size_t)512 * 1024, 0, (size_t)256 * 1024}; \
        EpiGate E{WSP(bf16_t, WS_RD), WSP(bf16_t, WS_RA), nullptr, 6.9053396600248786e-4f, 0, 512}; \
        pg8::gemm_phase<EpiGate>(ldsl, C.tid, 1024, 8192, 1024, S, E); } PHASE_END \
    GEMM_OUT(WS_RD, XCUR)

#define LAYER_C(XCUR) \
    PHASE_BEGIN REP(2) { int base = 0; \
        conv_mat(C, args.in[12] + DI, 2 * DI, DM, DI, WSP(bf16_t, WS_WIN) + (size_t)DI * DM, 0, base); \
        copy_cvt(C, args.in[12], 2 * DI, DM, DI, WSP(bf16_t, WS_WIN) + (size_t)2 * DI * DM); \
        conv_mat(C, args.in[15], DM, DI, DM, WSP(bf16_t, WS_WOUT), 0, base); \
        for (int g = 0; g < 4; ++g) conv_mat(C, args.in[13] + (size_t)g * 1024 * 1024, 1024, 1024, 1024, WSP(bf16_t, WS_WMIX) + (size_t)g * 1024 * 1024, 0, base); \
        norm_phase(C, XCUR, args.in[11], WSP(bf16_t, WS_RB)); } PHASE_END \
    PHASE_BEGIN {   \
        pg8::Sched S{4, 8, 4 * 4 * 8, C.G, C.bid, 1, WSP(bf16_t, WS_WMIX), WSP(bf16_t, WS_WIN) + (size_t)2 * DI * DM, (size_t)1024 * 1024, 0, (size_t)256 * 1024, 1024, 0, (size_t)256 * DI}; \
        EpiW E{WSP(bf16_t, WS_WIN), args.in[14]}; \
        pg8::gemm_phase<EpiW>(ldsl, C.tid, 1024, 1024, DI, S, E); } PHASE_END \
    PHASE_BEGIN REP(16) { \
        pg8::Sched S{64, 32, 64 * 32, C.G, C.bid, 1, WSP(bf16_t, WS_RB), WSP(bf16_t, WS_WIN), 0, 0, (size_t)256 * DM, 0, 0, (size_t)256 * DM}; \
        EpiBC1 E{WSP(bf16_t, WS_RC), WSP(bf16_t, WS_RA)}; \
        pg8::gemm_phase<EpiBC1>(ldsl, C.tid, DM, DM, DM, S, E); } PHASE_END \
    PHASE_BEGIN REP(128) { pool_phase(C, WSP(bf16_t, WS_RC), WSP(bf16_t, WS_RA), WSP(bf16_t, WS_RE)); } PHASE_END \
    GEMM_OUT(WS_RE, XCUR)

__global__ void __launch_bounds__(NTHR, 2) fwd_mega(Args args) {
    extern __shared__ __attribute__((aligned(16))) unsigned char lds_raw[];
    cg::grid_group grid = cg::this_grid();
    int ph = 0; unsigned nbar = 0;
    const int lo = args.ph_lo, hi = args.ph_hi;
    if (blockIdx.x == 0 && threadIdx.x < 64) __hip_atomic_store((unsigned*)(args.ws + WS_BAR) + 64 * threadIdx.x, 0u, __ATOMIC_RELAXED, __HIP_MEMORY_SCOPE_AGENT);
    LAYER_A(0, args.in[0], true)
#if RUN_B
    LAYER_B(args.out)
#endif
#if RUN_C
    LAYER_C(args.out)
#endif
#if RUN_A2
    LAYER_A(1, args.out, false)
#endif
    PHASE_BEGIN { final_norm_phase(C, args.out, args.in[16]); } PHASE_END
}

extern "C" void kernel_launch(void* const* d_in, const int* in_sizes, int n_in, void* d_out, int out_size, void* d_ws, size_t ws_size, hipStream_t stream) {
    static int grid = 0;
    if (grid == 0) {
        if (n_in != 17 || ws_size < WS_END) { fprintf(stderr, "kernel_launch: unexpected n_in %d / ws_size %zu (need %zu)\n", n_in, ws_size, (size_t)WS_END); grid = -1; return; }
        int dev = 0, cus = 0, per_cu = 0;
        hipGetDevice(&dev); hipDeviceGetAttribute(&cus, hipDeviceAttributeMultiprocessorCount, dev);
        if (hipFuncSetAttribute((const void*)fwd_mega, hipFuncAttributeMaxDynamicSharedMemorySize, LDS_BYTES) != hipSuccess) { fprintf(stderr, "kernel_launch: hipFuncSetAttribute failed\n"); grid = -1; return; }
        if (hipOccupancyMaxActiveBlocksPerMultiprocessor(&per_cu, (const void*)fwd_mega, NTHR, LDS_BYTES) != hipSuccess || per_cu < 1) { fprintf(stderr, "kernel_launch: occupancy query says %d\n", per_cu); per_cu = 1; }
        (void)hipGetLastError();
        grid = cus;
        fprintf(stderr, "kernel_launch: grid %d (per_cu %d), ws %zu\n", grid, per_cu, ws_size);
    }
    if (grid < 0) return;
    Args a{};
    for (int i = 0; i < 17; ++i) a.in[i] = (const float*)d_in[i];
    a.out = (float*)d_out; a.ws = (unsigned char*)d_ws;
    hipError_t e = hipSuccess;
#if MULTI_LAUNCH
    for (int p = 0; p < 20 && e == hipSuccess; ++p) { a.ph_lo = p; a.ph_hi = p + 1; void* kargs[] = {&a};
        e = hipLaunchCooperativeKernel((const void*)fwd_mega, dim3(grid), dim3(NTHR), kargs, LDS_BYTES, stream); }
#else
    a.ph_lo = 0; a.ph_hi = 1000;
    void* kargs[] = {&a};
    e = hipLaunchCooperativeKernel((const void*)fwd_mega, dim3(grid), dim3(NTHR), kargs, LDS_BYTES, stream);
#endif
    if (e != hipSuccess) fprintf(stderr, "kernel_launch: cooperative launch failed: %s\n", hipGetErrorString(e));
}
```

```cpp
#include <hip/hip_runtime.h>
#include <hip/hip_cooperative_groups.h>
#include <cstdio>
#include <cstdint>
namespace cg = cooperative_groups;

#define LAS __attribute__((address_space(3)))
typedef unsigned short bf16_t;
typedef short bf16x8 __attribute__((ext_vector_type(8)));
typedef float f32x4 __attribute__((ext_vector_type(4)));
typedef unsigned u32x4 __attribute__((ext_vector_type(4)));
typedef unsigned u32x2 __attribute__((ext_vector_type(2)));

constexpr int MTOK = 16384, DM = 2048, DI = 4096, SEQ = 4096;
constexpr float EPS = 1e-6f;
constexpr size_t MiB = (size_t)1 << 20;
constexpr size_t WS_WIN = 0, WS_WOUT = 48 * MiB, WS_WMIX = 64 * MiB, WS_WMTB = 72 * MiB, WS_CS = 76 * MiB, WS_M1 = 77 * MiB, WS_M2 = 78 * MiB;
constexpr size_t WS_RA = 80 * MiB, WS_RB = 208 * MiB, WS_RC = 336 * MiB, WS_RD = 464 * MiB, WS_RE = 592 * MiB, WS_SS = 720 * MiB, WS_BAR = 724 * MiB, WS_END = 725 * MiB;
constexpr int NTHR = 512;
constexpr int LDS_BYTES = 131072;
#ifndef MULTI_LAUNCH
#define MULTI_LAUNCH 0
#endif
#define RUN_B 1
#define RUN_C 1
#define RUN_A2 1
#ifndef DUP_MASK
#define DUP_MASK 0
#endif
#define REP(bit) for (int rep_ = 0; rep_ < (((DUP_MASK) & (bit)) ? 2 : 1); ++rep_)

typedef float f32x2_t __attribute__((ext_vector_type(2)));
typedef __bf16 bf16x2_t __attribute__((ext_vector_type(2)));
__device__ __forceinline__ unsigned cvt_pk_bf16(float lo, float hi) { const f32x2_t v = {lo, hi}; const bf16x2_t r = __builtin_convertvector(v, bf16x2_t); return __builtin_bit_cast(unsigned, r); }
__device__ __forceinline__ float bf_lo(unsigned w) { return __uint_as_float(w << 16); }
__device__ __forceinline__ float bf_hi(unsigned w) { return __uint_as_float(w & 0xffff0000u); }
__device__ __forceinline__ float gelu_t(float x) {
    const float y = x * (1.0f + 0.044715f * x * x);
    const float e = __builtin_amdgcn_exp2f(-2.0f * 0.7978845608f * 1.4426950409f * y);
    return x * __builtin_amdgcn_rcpf(1.0f + e);
}
__device__ __forceinline__ float silu_f(float x) { const float e = __builtin_amdgcn_exp2f(-1.4426950409f * x); return x * __builtin_amdgcn_rcpf(1.0f + e); }
__device__ __forceinline__ f32x2_t ex2_pk(f32x2_t a) { f32x2_t r; r.x = __builtin_amdgcn_exp2f(a.x); r.y = __builtin_amdgcn_exp2f(a.y); return r; }
__device__ __forceinline__ f32x2_t rcp_pk(f32x2_t a) { f32x2_t r; r.x = __builtin_amdgcn_rcpf(a.x); r.y = __builtin_amdgcn_rcpf(a.y); return r; }
__device__ __forceinline__ f32x2_t gelu_pk(f32x2_t v) { const f32x2_t y = v * (v * v * 0.044715f + 1.0f); return v * rcp_pk(ex2_pk(y * (-2.0f * 0.7978845608f * 1.4426950409f)) + 1.0f); }
__device__ __forceinline__ f32x2_t silu_pk(f32x2_t g) { return g * rcp_pk(ex2_pk(g * (-1.4426950409f)) + 1.0f); }
__device__ __forceinline__ f32x2_t gelu_silu_pk(f32x2_t u, f32x2_t g) {
    const f32x2_t y = u * (u * u * 0.044715f + 1.0f);
    const f32x2_t ea = ex2_pk(y * (-2.0f * 0.7978845608f * 1.4426950409f)), eg = ex2_pk(g * (-1.4426950409f));
    return (u * g) * rcp_pk((ea + 1.0f) * (eg + 1.0f));
}

namespace pg8 {
constexpr int BM = 256, BK = 64, HALF = 128, HTB = HALF * BK * 2, STAGE_BYTES = 8 * HTB, NXCD = 8, WGM = 8;
__host__ __device__ __forceinline__ int lds_byte(int r, int c) { const int st = (r >> 4) * 2 + (c >> 5), rr = r & 15, cc = c & 31, ob = rr * 64 + cc * 2; return st * 1024 + (ob ^ (((ob >> 9) & 1) << 5)); }
__host__ __device__ __forceinline__ void stage_rc(int b, int& R, int& C) { const int st = b / 1024, sb = b % 1024, swz = sb ^ (((sb >> 9) & 1) << 5); R = (st >> 1) * 16 + swz / 64; C = (st & 1) * 32 + (swz % 64) / 2; }
__host__ __device__ __forceinline__ int perm32(int rho) { const int n = rho >> 4, i = rho & 15; return 8 * (i >> 2) + 4 * n + (i & 3); }

struct Unit { const char* a; const char* b; int p, pm, pn; };

struct Sched {
    int nM, nN, nwg, G, c, P2;
    const bf16_t* A; const bf16_t* B;
    size_t sA1, sA2, sAm, sB1, sB2, sBn;
    __device__ __forceinline__ bool next(int i, Unit& u) const {
        const long L = (long)i * G + c; if (L >= nwg) return false;
        int wgid = (int)L; { const int q = nwg / NXCD, r = nwg % NXCD, xcd = wgid % NXCD, off = wgid / NXCD; wgid = (xcd < r ? xcd * (q + 1) : r * (q + 1) + (xcd - r) * q) + off; }
        const int per = nM * nN; const int p = wgid / per, w = wgid % per;
        const int nig = WGM * nN, gid = w / nig, fm = gid * WGM, gsz = (nM - fm) < WGM ? (nM - fm) : WGM;
        u.p = p; u.pm = fm + ((w % nig) % gsz); u.pn = (w % nig) / gsz;
        const int p1 = p / P2, p2 = p % P2;
        u.a = (const char*)(A + (size_t)p1 * sA1 + (size_t)p2 * sA2 + (size_t)u.pm * sAm);
        u.b = (const char*)(B + (size_t)p1 * sB1 + (size_t)p2 * sB2 + (size_t)u.pn * sBn);
        return true;
    }
};

template <class Epi>
__device__ __forceinline__ void gemm_phase(LAS unsigned char* lds, const int tid, const int K, const int lda, const int ldb, const Sched& S, const Epi& E) {
    const int wid = __builtin_amdgcn_readfirstlane(tid >> 6), lane = tid & 63, wr = wid >> 2, wc = wid & 3, fr = lane & 15, fq = lane >> 4;
    const int nt = K / BK;
    unsigned voffA[2], voffB[2];
#pragma unroll
    for (int i = 0; i < 2; ++i) { int R, C; stage_rc(tid * 16 + i * 8192, R, C); const int Rb = Epi::PERM ? ((R & ~31) + perm32(R & 31)) : R;
        voffA[i] = (unsigned)(R * lda + C) * 2u; voffB[i] = (unsigned)(Rb * ldb + C) * 2u; }
    const size_t kstep = (size_t)(BK * 2);
    const size_t hstepA = (size_t)HALF * lda * 2, hstepB = (size_t)HALF * ldb * 2;
    const unsigned ldsw = (unsigned)wid * 1024u;
    const int aoff = lds_byte(wr * 64 + fr, fq * 8), boff = lds_byte(wc * 32 + fr, fq * 8);
#define PG8_SA(b, h) (((b) * 2 + (h)) * HTB)
#define PG8_SB(b, h) ((4 + (b) * 2 + (h)) * HTB)
#define PG8_STAGE(bufoff, gbase, voff) do { _Pragma("unroll") for (int _i = 0; _i < 2; ++_i) \
        __builtin_amdgcn_global_load_lds((const unsigned*)((const char*)(gbase) + (voff)[_i]), (LAS unsigned*)(lds + (bufoff) + ldsw + _i * 8192), 16, 0, 0); } while (0)
#define PG8_LDA(dst, b, h) do { _Pragma("unroll") for (int m = 0; m < 4; ++m) _Pragma("unroll") for (int k = 0; k < 2; ++k) dst[m][k] = *(const LAS bf16x8*)(lds + PG8_SA(b, h) + aoff + m * 2048 + k * 1024); } while (0)
#define PG8_LDB(dst, b, h) do { _Pragma("unroll") for (int n = 0; n < 2; ++n) _Pragma("unroll") for (int k = 0; k < 2; ++k) dst[n][k] = *(const LAS bf16x8*)(lds + PG8_SB(b, h) + boff + n * 2048 + k * 1024); } while (0)
#define PG8_MMA(ai, bj, At, Bt) do { __builtin_amdgcn_s_setprio(1); _Pragma("unroll") for (int m = 0; m < 4; ++m) _Pragma("unroll") for (int n = 0; n < 2; ++n) _Pragma("unroll") for (int k = 0; k < 2; ++k) \
        acc[ai][bj][m][n] = __builtin_amdgcn_mfma_f32_16x16x32_bf16(Bt[n][k], At[m][k], acc[ai][bj][m][n], 0, 0, 0); __builtin_amdgcn_s_setprio(0); } while (0)
#define PG8_WAIT_V(n) asm volatile("s_waitcnt vmcnt(" #n ")" ::: "memory")
#define PG8_WAIT_L(n) asm volatile("s_waitcnt lgkmcnt(" #n ")" ::: "memory")
#define PG8_BAR __builtin_amdgcn_s_barrier()
#define PG8_SCHED __builtin_amdgcn_sched_barrier(0)
    Unit cur, nxt; int ui = 0;
    if (!S.next(0, cur)) return;
    f32x4 acc[2][2][4][2];
#pragma unroll
    for (int a = 0; a < 2; ++a)
#pragma unroll
        for (int b = 0; b < 2; ++b)
#pragma unroll
            for (int m = 0; m < 4; ++m)
#pragma unroll
                for (int n = 0; n < 2; ++n) acc[a][b][m][n] = (f32x4){0.f, 0.f, 0.f, 0.f};
    bf16x8 At[4][2], B0[2][2], B1[2][2];
    const char* cA = cur.a; const char* cB = cur.b;
    PG8_STAGE(PG8_SB(0, 0), cB, voffB); PG8_STAGE(PG8_SB(0, 1), cB + hstepB, voffB); PG8_STAGE(PG8_SA(0, 0), cA, voffA); PG8_STAGE(PG8_SA(0, 1), cA + hstepA, voffA);
    if (wr == 1) PG8_BAR;
    PG8_WAIT_V(2); PG8_BAR;
    PG8_STAGE(PG8_SB(1, 0), cB + kstep, voffB); PG8_STAGE(PG8_SA(1, 0), cA + kstep, voffA); PG8_STAGE(PG8_SB(1, 1), cB + hstepB + kstep, voffB);
    PG8_WAIT_V(6); PG8_BAR;
    for (;;) {
        const bool has_next = S.next(ui + 1, nxt);
        const char* nA = has_next ? nxt.a : cA; const char* nB = has_next ? nxt.b : cB;
        for (int t = 0; t < nt; t += 2) {
            const bool last = (t == nt - 2);
            const char* a1 = cA + (size_t)(t + 1) * kstep;
            const char* a2 = last ? nA : cA + (size_t)(t + 2) * kstep; const char* b2 = last ? nB : cB + (size_t)(t + 2) * kstep;
            const char* a3 = a2 + kstep; const char* b3 = b2 + kstep;
            PG8_LDB(B0, 0, 0); PG8_LDB(B1, 0, 1); PG8_SCHED; PG8_LDA(At, 0, 0); PG8_STAGE(PG8_SA(1, 1), a1 + hstepA, voffA);
            PG8_WAIT_V(8); PG8_WAIT_L(0); PG8_BAR; PG8_MMA(0, 0, At, B0); PG8_MMA(0, 1, At, B1); PG8_BAR; PG8_SCHED;
            PG8_LDA(At, 0, 1); PG8_STAGE(PG8_SB(0, 0), b2, voffB); PG8_STAGE(PG8_SB(0, 1), b2 + hstepB, voffB); PG8_STAGE(PG8_SA(0, 0), a2, voffA);
            PG8_WAIT_V(8); PG8_WAIT_L(0); PG8_BAR; PG8_MMA(1, 0, At, B0); PG8_MMA(1, 1, At, B1); PG8_BAR; PG8_SCHED;
            PG8_LDB(B0, 1, 0); PG8_LDB(B1, 1, 1); PG8_SCHED; PG8_LDA(At, 1, 0); PG8_STAGE(PG8_SA(0, 1), a2 + hstepA, voffA);
            PG8_WAIT_V(8); PG8_WAIT_L(0); PG8_BAR; PG8_MMA(0, 0, At, B0); PG8_MMA(0, 1, At, B1); PG8_BAR; PG8_SCHED;
            PG8_LDA(At, 1, 1); PG8_STAGE(PG8_SB(1, 0), b3, voffB); PG8_STAGE(PG8_SB(1, 1), b3 + hstepB, voffB); PG8_STAGE(PG8_SA(1, 0), a3, voffA);
            PG8_WAIT_V(8); PG8_WAIT_L(0); PG8_BAR; PG8_MMA(1, 0, At, B0); PG8_MMA(1, 1, At, B1); PG8_BAR; PG8_SCHED;
        }
        if (wr == 0) PG8_BAR;
        E(acc, cur, wr, wc, fr, fq);
        if (!has_next) break;
#pragma unroll
        for (int a = 0; a < 2; ++a)
#pragma unroll
            for (int b = 0; b < 2; ++b)
#pragma unroll
                for (int m = 0; m < 4; ++m)
#pragma unroll
                    for (int n = 0; n < 2; ++n) acc[a][b][m][n] = (f32x4){0.f, 0.f, 0.f, 0.f};
        cur = nxt; cA = nA; cB = nB; ++ui;
        if (wr == 1) PG8_BAR;
    }
    PG8_WAIT_V(0);
    PG8_BAR;
#undef PG8_SA
#undef PG8_SB
#undef PG8_STAGE
#undef PG8_LDA
#undef PG8_LDB
#undef PG8_MMA
#undef PG8_WAIT_V
#undef PG8_WAIT_L
#undef PG8_BAR
#undef PG8_SCHED
}
}

typedef f32x4 AccT[2][2][4][2];

struct EpiA1 {
    static constexpr bool PERM = true;
    bf16_t* ug; bf16_t* gv; float* sumsq;
    __device__ __forceinline__ void operator()(const AccT& acc, const pg8::Unit& u, int wr, int wc, int fr, int fq) const {
        const int row0 = u.pm * 256 + wr * 64 + fr;
        if (u.pn < 32) {
            const int ch0 = u.pn * 128 + wc * 32 + 8 * fq;
#pragma unroll
            for (int ai = 0; ai < 2; ++ai)
#pragma unroll
                for (int m = 0; m < 4; ++m) {
                    const f32x4 U0 = acc[ai][0][m][0], U1 = acc[ai][0][m][1], G0 = acc[ai][1][m][0], G1 = acc[ai][1][m][1];
                    const f32x2_t r0 = gelu_silu_pk((f32x2_t){U0[0], U0[1]}, (f32x2_t){G0[0], G0[1]}), r1 = gelu_silu_pk((f32x2_t){U0[2], U0[3]}, (f32x2_t){G0[2], G0[3]});
                    const f32x2_t r2 = gelu_silu_pk((f32x2_t){U1[0], U1[1]}, (f32x2_t){G1[0], G1[1]}), r3 = gelu_silu_pk((f32x2_t){U1[2], U1[3]}, (f32x2_t){G1[2], G1[3]});
                    u32x4 w; w.x = cvt_pk_bf16(r0.x, r0.y); w.y = cvt_pk_bf16(r1.x, r1.y); w.z = cvt_pk_bf16(r2.x, r2.y); w.w = cvt_pk_bf16(r3.x, r3.y);
                    *(u32x4*)(ug + (size_t)(row0 + ai * 128 + m * 16) * DI + ch0) = w;
                }
        } else {
            const int chb = (u.pn - 32) * 256 + wc * 32 + 8 * fq;
#pragma unroll
            for (int ai = 0; ai < 2; ++ai)
#pragma unroll
                for (int m = 0; m < 4; ++m) {
                    const int row = row0 + ai * 128 + m * 16; float ss = 0.f;
#pragma unroll
                    for (int bj = 0; bj < 2; ++bj) {
                        const f32x4 a0 = acc[ai][bj][m][0], a1 = acc[ai][bj][m][1];
                        const f32x2_t r0 = gelu_pk((f32x2_t){a0[0], a0[1]}), r1 = gelu_pk((f32x2_t){a0[2], a0[3]}), r2 = gelu_pk((f32x2_t){a1[0], a1[1]}), r3 = gelu_pk((f32x2_t){a1[2], a1[3]});
                        const f32x2_t q = (r0 * r0 + r1 * r1) + (r2 * r2 + r3 * r3); ss += q.x + q.y;
                        u32x4 w; w.x = cvt_pk_bf16(r0.x, r0.y); w.y = cvt_pk_bf16(r1.x, r1.y); w.z = cvt_pk_bf16(r2.x, r2.y); w.w = cvt_pk_bf16(r3.x, r3.y);
                        *(u32x4*)(gv + (size_t)row * DI + chb + bj * 128) = w;
                    }
                    ss += __shfl_xor(ss, 16); ss += __shfl_xor(ss, 32);
                    if (fq == 0) sumsq[(size_t)((u.pn - 32) * 4 + wc) * MTOK + row] = ss;
                }
        }
    }
};
struct EpiBC1 {
    static constexpr bool PERM = true;
    bf16_t* br; bf16_t* sg;
    __device__ __forceinline__ void operator()(const AccT& acc, const pg8::Unit& u, int wr, int wc, int fr, int fq) const {
        const int row0 = u.pm * 256 + wr * 64 + fr;
        const bool gate = u.pn >= 16;
        bf16_t* dst = gate ? sg : br;
        const int col0 = (gate ? u.pn - 16 : u.pn) * 256 + wc * 32 + 8 * fq;
#pragma unroll
        for (int ai = 0; ai < 2; ++ai)
#pragma unroll
            for (int m = 0; m < 4; ++m)
#pragma unroll
                for (int bj = 0; bj < 2; ++bj) {
                    f32x4 v0 = acc[ai][bj][m][0], v1 = acc[ai][bj][m][1];
                    if (gate) {
                        const f32x2_t r0 = silu_pk((f32x2_t){v0[0], v0[1]}), r1 = silu_pk((f32x2_t){v0[2], v0[3]}), r2 = silu_pk((f32x2_t){v1[0], v1[1]}), r3 = silu_pk((f32x2_t){v1[2], v1[3]});
                        v0 = (f32x4){r0.x, r0.y, r1.x, r1.y}; v1 = (f32x4){r2.x, r2.y, r3.x, r3.y};
                    }
                    u32x4 w; w.x = cvt_pk_bf16(v0[0], v0[1]); w.y = cvt_pk_bf16(v0[2], v0[3]); w.z = cvt_pk_bf16(v1[0], v1[1]); w.w = cvt_pk_bf16(v1[2], v1[3]);
                    *(u32x4*)(dst + (size_t)(row0 + ai * 128 + m * 16) * DI + col0 + bj * 128) = w;
                }
    }
};
struct EpiPre {
    static constexpr bool PERM = true;
    bf16_t* bt2;
    __device__ __forceinline__ void operator()(const AccT& acc, const pg8::Unit& u, int wr, int wc, int fr, int fq) const {
        const int g = u.p;
        const int d0 = u.pm * 256 + wr * 64 + fr, c0 = u.pn * 256 + wc * 32 + 8 * fq;
#pragma unroll
        for (int ai = 0; ai < 2; ++ai)
#pragma unroll
            for (int m = 0; m < 4; ++m)
#pragma unroll
                for (int bj = 0; bj < 2; ++bj) {
                    const f32x4 v0 = acc[ai][bj][m][0], v1 = acc[ai][bj][m][1];
                    u32x4 w; w.x = cvt_pk_bf16(v0[0], v0[1]); w.y = cvt_pk_bf16(v0[2], v0[3]); w.z = cvt_pk_bf16(v1[0], v1[1]); w.w = cvt_pk_bf16(v1[2], v1[3]);
                    *(u32x4*)(bt2 + ((size_t)(g * 512 + d0 + ai * 128 + m * 16)) * 1024 + c0 + bj * 128) = w;
                }
    }
};
struct EpiW {
    static constexpr bool PERM = true;
    bf16_t* w; const float* cscale;
    __device__ __forceinline__ void operator()(const AccT& acc, const pg8::Unit& u, int wr, int wc, int fr, int fq) const {
        const int row0 = u.p * 1024 + u.pm * 256 + wr * 64 + fr, col0 = u.pn * 256 + wc * 32 + 8 * fq;
#pragma unroll
        for (int ai = 0; ai < 2; ++ai)
#pragma unroll
            for (int m = 0; m < 4; ++m) {
                const int row = row0 + ai * 128 + m * 16; const float sc = cscale[row];
#pragma unroll
                for (int bj = 0; bj < 2; ++bj) {
                    const f32x4 v0 = acc[ai][bj][m][0] * sc, v1 = acc[ai][bj][m][1] * sc;
                    u32x4 q; q.x = cvt_pk_bf16(v0[0], v0[1]); q.y = cvt_pk_bf16(v0[2], v0[3]); q.z = cvt_pk_bf16(v1[0], v1[1]); q.w = cvt_pk_bf16(v1[2], v1[3]);
                    *(u32x4*)(w + (size_t)row * DM + col0 + bj * 128) = q;
                }
            }
    }
};
struct EpiGate {
    static constexpr bool PERM = true;
    bf16_t* t; const bf16_t* sg; const float* cscale; float sc; int rowsPerP, colsPerP;
    __device__ __forceinline__ void operator()(const AccT& acc, const pg8::Unit& u, int wr, int wc, int fr, int fq) const {
        const int row0 = u.p * rowsPerP + u.pm * 256 + wr * 64 + fr, col0 = u.p * colsPerP + u.pn * 256 + wc * 32 + 8 * fq;
        u32x4 gq[2][4][2];
#pragma unroll
        for (int ai = 0; ai < 2; ++ai)
#pragma unroll
            for (int m = 0; m < 4; ++m)
#pragma unroll
                for (int bj = 0; bj < 2; ++bj) gq[ai][m][bj] = *(const u32x4*)(sg + (size_t)(row0 + ai * 128 + m * 16) * DI + col0 + bj * 128);
        f32x4 s0[2], s1[2];
#pragma unroll
        for (int bj = 0; bj < 2; ++bj) {
            if (cscale) { s0[bj] = *(const f32x4*)(cscale + col0 + bj * 128); s1[bj] = *(const f32x4*)(cscale + col0 + bj * 128 + 4); }
            else { s0[bj] = (f32x4){sc, sc, sc, sc}; s1[bj] = s0[bj]; }
        }
#pragma unroll
        for (int ai = 0; ai < 2; ++ai)
#pragma unroll
            for (int m = 0; m < 4; ++m)
#pragma unroll
                for (int bj = 0; bj < 2; ++bj) {
                    const size_t off = (size_t)(row0 + ai * 128 + m * 16) * DI + col0 + bj * 128;
                    const u32x4 g = gq[ai][m][bj];
                    const f32x4 v0 = acc[ai][bj][m][0] * s0[bj], v1 = acc[ai][bj][m][1] * s1[bj];
                    u32x4 w;
                    w.x = cvt_pk_bf16(v0[0] * bf_lo(g.x), v0[1] * bf_hi(g.x)); w.y = cvt_pk_bf16(v0[2] * bf_lo(g.y), v0[3] * bf_hi(g.y));
                    w.z = cvt_pk_bf16(v1[0] * bf_lo(g.z), v1[1] * bf_hi(g.z)); w.w = cvt_pk_bf16(v1[2] * bf_lo(g.w), v1[3] * bf_hi(g.w));
                    *(u32x4*)(t + off) = w;
                }
    }
};
struct EpiOut {
    static constexpr bool PERM = false;
    const float* xold; float* xnew;
    __device__ __forceinline__ void operator()(const AccT& acc, const pg8::Unit& u, int wr, int wc, int fr, int fq) const {
        const int row0 = u.pm * 256 + wr * 64 + fr, col0 = u.pn * 256 + wc * 32 + 4 * fq;
#pragma unroll
        for (int ai = 0; ai < 2; ++ai) {
            f32x4 o[4][2][2];
#pragma unroll
            for (int m = 0; m < 4; ++m)
#pragma unroll
                for (int bj = 0; bj < 2; ++bj)
#pragma unroll
                    for (int n = 0; n < 2; ++n) o[m][bj][n] = *(const f32x4*)(xold + (size_t)(row0 + ai * 128 + m * 16) * DM + col0 + bj * 128 + n * 16);
            asm volatile("" ::: "memory");
#pragma unroll
            for (int m = 0; m < 4; ++m)
#pragma unroll
                for (int bj = 0; bj < 2; ++bj)
#pragma unroll
                    for (int n = 0; n < 2; ++n) *(f32x4*)(xnew + (size_t)(row0 + ai * 128 + m * 16) * DM + col0 + bj * 128 + n * 16) = o[m][bj][n] + acc[ai][bj][m][n];
            asm volatile("" ::: "memory");
        }
    }
};

struct Ctx { int tid, lane, wave, G, bid; unsigned char* lds; };

__device__ __forceinline__ void conv_tile(const Ctx& C, const float* src, int ldsrc, int k0, int c0, bf16_t* dst, int ldd, int n0) {
    float* T = (float*)C.lds;
    const int kk = C.tid >> 4, c4 = (C.tid & 15) * 4;
#pragma unroll
    for (int i = 0; i < 2; ++i) {
        const int k = kk + 32 * i;
        const f32x4 v = *(const f32x4*)(src + (size_t)(k0 + k) * ldsrc + c0 + c4);
        T[k * 65 + c4 + 0] = v[0]; T[k * 65 + c4 + 1] = v[1]; T[k * 65 + c4 + 2] = v[2]; T[k * 65 + c4 + 3] = v[3];
    }
    __syncthreads();
    const int n = C.tid >> 3, k8 = (C.tid & 7) * 8;
    u32x4 w;
    w.x = cvt_pk_bf16(T[(k8 + 0) * 65 + n], T[(k8 + 1) * 65 + n]); w.y = cvt_pk_bf16(T[(k8 + 2) * 65 + n], T[(k8 + 3) * 65 + n]);
    w.z = cvt_pk_bf16(T[(k8 + 4) * 65 + n], T[(k8 + 5) * 65 + n]); w.w = cvt_pk_bf16(T[(k8 + 6) * 65 + n], T[(k8 + 7) * 65 + n]);
    *(u32x4*)(dst + (size_t)(n0 + n) * ldd + k0 + k8) = w;
    __syncthreads();
}
__device__ __forceinline__ void copy_cvt(const Ctx& C, const float* src, int ldsrc, int rows, int ncols, bf16_t* dst) {
    const int per = ncols / 8, total = rows * per;
    for (int i = C.bid * NTHR + C.tid; i < total; i += C.G * NTHR) {
        const int r = i / per, c = (i % per) * 8;
        const f32x4 a = *(const f32x4*)(src + (size_t)r * ldsrc + c), b = *(const f32x4*)(src + (size_t)r * ldsrc + c + 4);
        u32x4 w; w.x = cvt_pk_bf16(a[0], a[1]); w.y = cvt_pk_bf16(a[2], a[3]); w.z = cvt_pk_bf16(b[0], b[1]); w.w = cvt_pk_bf16(b[2], b[3]);
        *(u32x4*)(dst + (size_t)r * ncols + c) = w;
    }
}
__device__ __forceinline__ void conv_mat(const Ctx& C, const float* src, int ldsrc, int K, int Nd, bf16_t* dst, int mode, int& base) {
    const int tk = K / 64, tn = Nd / 64, ntile = tk * tn;
    int start = (C.bid - (base % C.G) + C.G) % C.G;
    for (int t = start; t < ntile; t += C.G) {
        const int in_ = t / tk, ik = t % tk;
        const int n0 = in_ * 64;
        int c0 = n0;
        if (mode == 1) {
            if (n0 < 8192) { const int tile = n0 >> 8, r = n0 & 255; c0 = (r < 128) ? tile * 128 + r : 8192 + tile * 128 + (r - 128); }
            else c0 = 4096 + (n0 - 8192);
        }
        conv_tile(C, src, ldsrc, ik * 64, c0, dst, K, n0);
    }
    base += ntile;
}
__device__ __forceinline__ void norm_phase(const Ctx& C, const float* x, const float* gain, bf16_t* h) {
    for (int row = C.bid * 8 + C.wave; row < MTOK; row += C.G * 8) {
        const float* xr = x + (size_t)row * DM;
        f32x4 v[8]; float ss = 0.f;
#pragma unroll
        for (int j = 0; j < 4; ++j) {
            v[2 * j] = *(const f32x4*)(xr + (j * 64 + C.lane) * 8); v[2 * j + 1] = *(const f32x4*)(xr + (j * 64 + C.lane) * 8 + 4);
#pragma unroll
            for (int e = 0; e < 4; ++e) ss += v[2 * j][e] * v[2 * j][e] + v[2 * j + 1][e] * v[2 * j + 1][e];
        }
#pragma unroll
        for (int o = 1; o < 64; o <<= 1) ss += __shfl_xor(ss, o);
        const float rs = __builtin_amdgcn_rsqf(ss * (1.0f / DM) + EPS);
#pragma unroll
        for (int j = 0; j < 4; ++j) {
            const int c = (j * 64 + C.lane) * 8;
            const f32x4 g0 = *(const f32x4*)(gain + c), g1 = *(const f32x4*)(gain + c + 4);
            const f32x4 a = v[2 * j] * rs * g0, b = v[2 * j + 1] * rs * g1;
            u32x4 w; w.x = cvt_pk_bf16(a[0], a[1]); w.y = cvt_pk_bf16(a[2], a[3]); w.z = cvt_pk_bf16(b[0], b[1]); w.w = cvt_pk_bf16(b[2], b[3]);
            *(u32x4*)(h + (size_t)row * DM + c) = w;
        }
    }
}
__device__ __forceinline__ void final_norm_phase(const Ctx& C, float* x, const float* gain) {
    for (int row = C.bid * 8 + C.wave; row < MTOK; row += C.G * 8) {
        float* xr = x + (size_t)row * DM;
        f32x4 v[8]; float ss = 0.f;
#pragma unroll
        for (int j = 0; j < 8; ++j) {
            v[j] = *(const f32x4*)(xr + (j * 64 + C.lane) * 4);
#pragma unroll
            for (int e = 0; e < 4; ++e) ss += v[j][e] * v[j][e];
        }
#pragma unroll
        for (int o = 1; o < 64; o <<= 1) ss += __shfl_xor(ss, o);
        const float rs = __builtin_amdgcn_rsqf(ss * (1.0f / DM) + EPS);
#pragma unroll
        for (int j = 0; j < 8; ++j) {
            const int c = (j * 64 + C.lane) * 4;
            const f32x4 g0 = *(const f32x4*)(gain + c);
            *(f32x4*)(xr + c) = v[j] * rs * g0;
        }
    }
}
__device__ __forceinline__ void gen_tables(const Ctx& C, bf16_t* cs, bf16_t* m1, bf16_t* m2) {
    const int gt = C.bid * NTHR + C.tid, GT = C.G * NTHR;
    for (int i = gt; i < 1024 * 512 / 8; i += GT) {
        const int n = i / 64, d0 = (i % 64) * 8; const int c = n & 511; const bool sn = n >= 512;
        float v[8];
#pragma unroll
        for (int e = 0; e < 8; ++e) { const float rev = (float)((c * (d0 + e)) & 511) * (1.0f / 512.0f); v[e] = sn ? __builtin_amdgcn_sinf(rev) : __builtin_amdgcn_cosf(rev); }
        u32x4 w; w.x = cvt_pk_bf16(v[0], v[1]); w.y = cvt_pk_bf16(v[2], v[3]); w.z = cvt_pk_bf16(v[4], v[5]); w.w = cvt_pk_bf16(v[6], v[7]);
        *(u32x4*)(cs + (size_t)i * 8) = w;
    }
    for (int i = gt; i < 64 * 128 * 64 / 8; i += GT) {
        const int s2 = i >> 10, r = (i >> 3) & 127, s10 = (i & 7) * 8; const int k1 = r & 63; const bool sn = r >= 64;
        float v[8];
#pragma unroll
        for (int e = 0; e < 8; ++e) { const float rev = (float)(((64 * (s10 + e) + s2) * k1) & 4095) * (1.0f / 4096.0f); v[e] = sn ? __builtin_amdgcn_sinf(rev) : __builtin_amdgcn_cosf(rev); }
        u32x4 w; w.x = cvt_pk_bf16(v[0], v[1]); w.y = cvt_pk_bf16(v[2], v[3]); w.z = cvt_pk_bf16(v[4], v[5]); w.w = cvt_pk_bf16(v[6], v[7]);
        *(u32x4*)(m1 + (size_t)i * 8) = w;
    }
    for (int i = gt; i < 128 * 128 / 8; i += GT) {
        const int r = i >> 4, c0 = (i & 15) * 8; const int k2 = r & 63; const bool rim = r >= 64;
        float v[8];
#pragma unroll
        for (int e = 0; e < 8; ++e) { const int c = c0 + e, s2 = c & 63; const bool cim = c >= 64; const float rev = (float)((s2 * k2) & 63) * (1.0f / 64.0f);
            const float cs_ = __builtin_amdgcn_cosf(rev), sn_ = __builtin_amdgcn_sinf(rev);
            v[e] = rim ? (cim ? -cs_ : -sn_) : (cim ? -sn_ : cs_); }
        u32x4 w; w.x = cvt_pk_bf16(v[0], v[1]); w.y = cvt_pk_bf16(v[2], v[3]); w.z = cvt_pk_bf16(v[4], v[5]); w.w = cvt_pk_bf16(v[6], v[7]);
        *(u32x4*)(m2 + (size_t)i * 8) = w;
    }
}
typedef short s16x4 __attribute__((ext_vector_type(4)));
constexpr int SK_PITCH = 144, SK_AUX_OFF = 34816, SK_SLAB_OFF = 37376, SK_SLAB_BYTES = 128 * SK_PITCH;
struct SkItem { const bf16_t* in; size_t in_stride; bf16_t* out; const bf16_t* mul; const float* vg; const float* bs; };
template <int MODE> __device__ __forceinline__ size_t sk_out_off(int r) {
    if (MODE == 0) return (size_t)r * DI;
    if (MODE == 1) return (size_t)((r & 63) * 128 + (r >> 6) * 64) * DI;
    return (size_t)(r & 63) * 64 * 8192 + (size_t)(r >> 6) * 512;
}
template <int MODE, int KQ>
__device__ __forceinline__ void sk_core(const Ctx& C, LAS unsigned char* L, const SkItem& it) {
    constexpr int MP = (KQ + 8) * 2;
    const int pair = C.wave >> 1, hw = C.wave & 1, lp = hw * 64 + C.lane;
    const int fr = C.lane & 15, fq = C.lane >> 4, trq = (C.lane & 15) >> 2, trp = C.lane & 3;
    LAS unsigned char* slab = L + SK_SLAB_OFF + pair * SK_SLAB_BYTES;
    __syncthreads();
    {
        u32x4 v[KQ / 16];
#pragma unroll
        for (int i = 0; i < KQ / 16; ++i) v[i] = *(const u32x4*)(it.in + (size_t)((lp >> 3) + 16 * i) * it.in_stride + pair * 64 + (lp & 7) * 8);
#pragma unroll
        for (int i = 0; i < KQ / 16; ++i) *(LAS u32x4*)(slab + ((lp >> 3) + 16 * i) * SK_PITCH + (lp & 7) * 16) = v[i];
    }
    __syncthreads();
    f32x4 acc[4][4];
#pragma unroll
    for (int cb = 0; cb < 4; ++cb)
#pragma unroll
        for (int pb = 0; pb < 4; ++pb) acc[cb][pb] = (f32x4){0.f, 0.f, 0.f, 0.f};
#pragma unroll
    for (int kb = 0; kb < KQ / 32; ++kb) {
        bf16x8 af[4];
#pragma unroll
        for (int cb = 0; cb < 4; ++cb) {
            const s16x4 t0 = __builtin_amdgcn_ds_read_tr16_b64_v4i16((LAS s16x4*)(slab + (32 * kb + 8 * fq + trq) * SK_PITCH + (16 * cb + 4 * trp) * 2));
            const s16x4 t1 = __builtin_amdgcn_ds_read_tr16_b64_v4i16((LAS s16x4*)(slab + (32 * kb + 8 * fq + 4 + trq) * SK_PITCH + (16 * cb + 4 * trp) * 2));
            af[cb] = (bf16x8){t0[0], t0[1], t0[2], t0[3], t1[0], t1[1], t1[2], t1[3]};
        }
#pragma unroll
        for (int pb = 0; pb < 4; ++pb) {
            const bf16x8 bfr = *(const LAS bf16x8*)(L + (64 * hw + pb * 16 + fr) * MP + (kb * 32 + fq * 8) * 2);
#pragma unroll
            for (int cb = 0; cb < 4; ++cb) acc[cb][pb] = __builtin_amdgcn_mfma_f32_16x16x32_bf16(af[cb], bfr, acc[cb][pb], 0, 0, 0);
        }
    }
    __syncthreads();
#pragma unroll
    for (int cb = 0; cb < 4; ++cb) {
        f32x4 vg = (f32x4){1.f, 1.f, 1.f, 1.f};
        if (MODE == 0) vg = *(const f32x4*)(it.vg + pair * 64 + cb * 16 + 4 * fq);
#pragma unroll
        for (int pb = 0; pb < 4; ++pb) {
            const int row = 64 * hw + pb * 16 + fr;
            f32x4 v = acc[cb][pb];
            if (MODE == 0) v = v * vg + it.bs[row];
            u32x2 w; w.x = cvt_pk_bf16(v[0], v[1]); w.y = cvt_pk_bf16(v[2], v[3]);
            *(LAS u32x2*)(slab + row * SK_PITCH + (cb * 16 + 4 * fq) * 2) = w;
        }
    }
    u32x4 mv[8];
    if (MODE == 0) {
#pragma unroll
        for (int i = 0; i < 8; ++i) mv[i] = *(const u32x4*)(it.mul + (size_t)(64 * hw + i * 8 + (C.lane >> 3)) * DI + pair * 64 + (C.lane & 7) * 8);
    }
#pragma unroll
    for (int i = 0; i < 8; ++i) {
        const int row = 64 * hw + i * 8 + (C.lane >> 3);
        u32x4 sv = *(const LAS u32x4*)(slab + row * SK_PITCH + (C.lane & 7) * 16);
        if (MODE == 0) {
            const u32x4 m = mv[i];
            sv.x = cvt_pk_bf16(bf_lo(sv.x) * bf_lo(m.x), bf_hi(sv.x) * bf_hi(m.x)); sv.y = cvt_pk_bf16(bf_lo(sv.y) * bf_lo(m.y), bf_hi(sv.y) * bf_hi(m.y));
            sv.z = cvt_pk_bf16(bf_lo(sv.z) * bf_lo(m.z), bf_hi(sv.z) * bf_hi(m.z)); sv.w = cvt_pk_bf16(bf_lo(sv.w) * bf_lo(m.w), bf_hi(sv.w) * bf_hi(m.w));
        }
        *(u32x4*)(it.out + sk_out_off<MODE>(row) + pair * 64 + (C.lane & 7) * 8) = sv;
    }
}
__device__ __forceinline__ void mixA_phase(const Ctx& C, const bf16_t* ug, const bf16_t* gv, const float* sumsq, const float* w_s, const float* b_s, const float* v_gain, bf16_t* t) {
    constexpr int WP = 136;
    LAS unsigned char* L = (LAS unsigned char*)C.lds;
    float* rstd = (float*)(C.lds + SK_AUX_OFF);
    float* red = (float*)(C.lds + SK_AUX_OFF + 512);
    bf16_t* Wl = (bf16_t*)C.lds;
    for (int hc = C.bid; hc < 256; hc += C.G) {
        const int n = hc >> 1, g0 = (hc & 1) * 4;
        __syncthreads();
        {
            const int r = C.tid & 127, part = C.tid >> 7; float a = 0.f;
#pragma unroll
            for (int i = 0; i < 16; ++i) a += sumsq[(size_t)(part * 16 + i) * MTOK + n * 128 + r];
            red[part * 128 + r] = a;
            __syncthreads();
            if (C.tid < 128) rstd[C.tid] = __builtin_amdgcn_rsqf(((red[C.tid] + red[128 + C.tid]) + (red[256 + C.tid] + red[384 + C.tid])) * (1.0f / DI) + EPS);
        }
        __syncthreads();
#pragma unroll 1
        for (int gi = 0; gi < 4; ++gi) {
            const int g = g0 + gi;
            {
                const int p = C.tid >> 2, q0 = (C.tid & 3) * 32;
                const float* wsrc = w_s + ((size_t)g * 128 + p) * 128 + q0;
#pragma unroll
                for (int j = 0; j < 4; ++j) {
                    const f32x4 a = *(const f32x4*)(wsrc + j * 8), b = *(const f32x4*)(wsrc + j * 8 + 4);
                    const int q = q0 + j * 8;
                    u32x4 w;
                    w.x = cvt_pk_bf16(a[0] * rstd[q + 0], a[1] * rstd[q + 1]); w.y = cvt_pk_bf16(a[2] * rstd[q + 2], a[3] * rstd[q + 3]);
                    w.z = cvt_pk_bf16(b[0] * rstd[q + 4], b[1] * rstd[q + 5]); w.w = cvt_pk_bf16(b[2] * rstd[q + 6], b[3] * rstd[q + 7]);
                    *(u32x4*)(Wl + p * WP + q) = w;
                }
            }
            const size_t off0 = (size_t)n * 128 * DI + g * 512;
#pragma unroll 1
            for (int h = 0; h < 2; ++h) {
                SkItem it{gv + off0 + h * 256, (size_t)DI, t + off0 + h * 256, ug + off0 + h * 256, v_gain + g * 512 + h * 256, b_s + g * 128};
                sk_core<0, 128>(C, L, it);
            }
        }
    }
}
__device__ __forceinline__ void fft1_phase(const Ctx& C, const bf16_t* xb, const bf16_t* m1, bf16_t* ap) {
    LAS unsigned char* L = (LAS unsigned char*)C.lds;
    for (int w = C.bid; w < 256; w += C.G) {
        const int s2 = w >> 2, sub = w & 3;
        __syncthreads();
#pragma unroll
        for (int i = 0; i < 2; ++i) { const int idx = C.tid * 8 + i * 4096, r = idx >> 6, c = idx & 63;
            *(LAS u32x4*)(L + r * 144 + c * 2) = *(const u32x4*)(m1 + (size_t)s2 * 8192 + idx); }
#pragma unroll 1
        for (int j = 0; j < 16; ++j) {
            const int combo = sub * 16 + j, b = combo >> 4, cblk = combo & 15;
            SkItem it{xb + (size_t)(b * SEQ + s2) * DI + cblk * 256, (size_t)64 * DI, ap + ((size_t)(b * 64) * 128 + s2) * DI + cblk * 256, nullptr, nullptr, nullptr};
            sk_core<1, 64>(C, L, it);
        }
    }
}
__device__ __forceinline__ void fft2_phase(const Ctx& C, const bf16_t* ap, const bf16_t* m2, bf16_t* cs) {
    LAS unsigned char* L = (LAS unsigned char*)C.lds;
    __syncthreads();
#pragma unroll
    for (int i = 0; i < 4; ++i) { const int idx = C.tid * 8 + i * 4096, r = idx >> 7, c = idx & 127;
        *(LAS u32x4*)(L + r * 272 + c * 2) = *(const u32x4*)(m2 + idx); }
#pragma unroll 1
    for (int item = C.bid; item < 4096; item += C.G) {
        const int cblk = item & 15, k1 = (item >> 4) & 63, b = item >> 10;
        SkItem it{ap + ((size_t)(b * 64 + k1) * 128) * DI + cblk * 256, (size_t)DI, cs + (size_t)(b * SEQ + k1) * 8192 + (cblk >> 1) * 1024 + (cblk & 1) * 256, nullptr, nullptr, nullptr};
        sk_core<2, 128>(C, L, it);
    }
}
template <int W>
__device__ __forceinline__ void pool_rows(const bf16_t* xc, const bf16_t* sg, bf16_t* p, int tok0, int ntok, int c8) {
    constexpr int LO = W / 2, TPI = 16 / W;
    for (int t0 = 0; t0 < ntok; t0 += TPI) {
        u32x4 q[TPI][W], gq[TPI];
#pragma unroll
        for (int tt = 0; tt < TPI; ++tt) {
            const int tok = tok0 + t0 + tt, spos = tok & (SEQ - 1), base = tok - spos;
            gq[tt] = *(const u32x4*)(sg + (size_t)tok * DI + c8);
#pragma unroll
            for (int j = 0; j < W; ++j) { int r = spos - LO + j; r = r < 0 ? 0 : (r > SEQ - 1 ? SEQ - 1 : r); q[tt][j] = *(const u32x4*)(xc + (size_t)(base + r) * DI + c8); }
        }
#pragma unroll
        for (int tt = 0; tt < TPI; ++tt) {
            const int tok = tok0 + t0 + tt, spos = tok & (SEQ - 1);
            float s[8] = {0.f, 0.f, 0.f, 0.f, 0.f, 0.f, 0.f, 0.f}; int cnt = 0;
#pragma unroll
            for (int j = 0; j < W; ++j) {
                const int r = spos - LO + j; const bool ok = (r >= 0) && (r <= SEQ - 1); const float f = ok ? 1.f : 0.f; cnt += ok ? 1 : 0;
                const u32x4 v = q[tt][j];
                s[0] += f * bf_lo(v.x); s[1] += f * bf_hi(v.x); s[2] += f * bf_lo(v.y); s[3] += f * bf_hi(v.y);
                s[4] += f * bf_lo(v.z); s[5] += f * bf_hi(v.z); s[6] += f * bf_lo(v.w); s[7] += f * bf_hi(v.w);
            }
            const float ic = 1.0f / (float)cnt; const u32x4 me = q[tt][LO]; const u32x4 g = gq[tt];
            u32x4 o;
            o.x = cvt_pk_bf16((s[0] * ic - bf_lo(me.x)) * bf_lo(g.x), (s[1] * ic - bf_hi(me.x)) * bf_hi(g.x)); o.y = cvt_pk_bf16((s[2] * ic - bf_lo(me.y)) * bf_lo(g.y), (s[3] * ic - bf_hi(me.y)) * bf_hi(g.y));
            o.z = cvt_pk_bf16((s[4] * ic - bf_lo(me.z)) * bf_lo(g.z), (s[5] * ic - bf_hi(me.z)) * bf_hi(g.z)); o.w = cvt_pk_bf16((s[6] * ic - bf_lo(me.w)) * bf_lo(g.w), (s[7] * ic - bf_hi(me.w)) * bf_hi(g.w));
            *(u32x4*)(p + (size_t)tok * DI + c8) = o;
        }
    }
}
__device__ __forceinline__ void pool_phase(const Ctx& C, const bf16_t* xc, const bf16_t* sg, bf16_t* p) {
    const int c8 = C.tid * 8; const int grp = C.wave >> 1;
    for (int blk = C.bid; blk < MTOK / 64; blk += C.G) {
        if (grp == 0) pool_rows<2>(xc, sg, p, blk * 64, 64, c8);
        else if (grp == 1) pool_rows<4>(xc, sg, p, blk * 64, 64, c8);
        else if (grp == 2) pool_rows<8>(xc, sg, p, blk * 64, 64, c8);
        else pool_rows<16>(xc, sg, p, blk * 64, 64, c8);
    }
}

__device__ __forceinline__ void grid_bar(unsigned* base, unsigned gen, unsigned G) {
    asm volatile("s_waitcnt vmcnt(0) lgkmcnt(0)" ::: "memory");
    __syncthreads();
    if (threadIdx.x == 0) {
        __builtin_amdgcn_fence(__ATOMIC_RELEASE, "agent");
        asm volatile("s_waitcnt vmcnt(0)" ::: "memory");
        unsigned* flag = base + 64 * (1 + (blockIdx.x >> 4));
        (void)__hip_atomic_fetch_add(base, 1u, __ATOMIC_RELAXED, __HIP_MEMORY_SCOPE_AGENT);
        if ((blockIdx.x & 15u) == 0u) {
            while (__hip_atomic_load(base, __ATOMIC_RELAXED, __HIP_MEMORY_SCOPE_AGENT) < gen * G) __builtin_amdgcn_s_sleep(1);
            __hip_atomic_store(flag, gen, __ATOMIC_RELAXED, __HIP_MEMORY_SCOPE_AGENT);
        } else {
            while (__hip_atomic_load(flag, __ATOMIC_RELAXED, __HIP_MEMORY_SCOPE_AGENT) < gen) __builtin_amdgcn_s_sleep(1);
        }
        __builtin_amdgcn_fence(__ATOMIC_ACQUIRE, "agent");
        asm volatile("s_waitcnt vmcnt(0)" ::: "memory");
    }
    __syncthreads();
}

struct Args { const float* in[17]; float* out; unsigned char* ws; int ph_lo, ph_hi; };

#define PHASE_BEGIN if (ph >= lo && ph < hi) { \
        unsigned char* ws = args.ws; asm volatile("" : "+s"(ws)); int tid_ = threadIdx.x; asm volatile("" : "+v"(tid_)); \
        Ctx C; C.tid = tid_; C.lane = tid_ & 63; C.wave = __builtin_amdgcn_readfirstlane(tid_ >> 6); C.G = gridDim.x; C.bid = blockIdx.x; C.lds = lds_raw; \
        LAS unsigned char* ldsl = (LAS unsigned char*)lds_raw; (void)ldsl; (void)ws;
#define PHASE_END   if (ph + 1 < hi) { if (ph == 0) grid.sync(); else { ++nbar; grid_bar((unsigned*)(args.ws + WS_BAR), nbar, gridDim.x); } } } ++ph;
#define WSP(T, off) ((T*)(ws + (off)))

#define GEMM_OUT(TBUF, XCUR) PHASE_BEGIN { \
        pg8::Sched S{64, 8, 64 * 8, C.G, C.bid, 1, WSP(bf16_t, TBUF), WSP(bf16_t, WS_WOUT), 0, 0, (size_t)256 * DI, 0, 0, (size_t)256 * DI}; \
        EpiOut E{XCUR, args.out}; \
        pg8::gemm_phase<EpiOut>(ldsl, C.tid, DI, DI, DI, S, E); } PHASE_END

#define LAYER_A(J, XCUR, FIRST) \
    PHASE_BEGIN REP(2) { int base = 0; \
        conv_mat(C, args.in[2] + (size_t)(J) * DM * 3 * DI, 3 * DI, DM, 3 * DI, WSP(bf16_t, WS_WIN), 1, base); \
        conv_mat(C, args.in[6] + (size_t)(J) * DI * DM, DM, DI, DM, WSP(bf16_t, WS_WOUT), 0, base); \
        if (FIRST) gen_tables(C, WSP(bf16_t, WS_CS), WSP(bf16_t, WS_M1), WSP(bf16_t, WS_M2)); \
        norm_phase(C, XCUR, args.in[1] + (size_t)(J) * DM, WSP(bf16_t, WS_RB)); } PHASE_END \
    PHASE_BEGIN REP(8) { \
        pg8::Sched S{64, 48, 64 * 48, C.G, C.bid, 1, WSP(bf16_t, WS_RB), WSP(bf16_t, WS_WIN), 0, 0, (size_t)256 * DM, 0, 0, (size_t)256 * DM}; \
        EpiA1 E{WSP(bf16_t, WS_RC), WSP(bf16_t, WS_RD), WSP(float, WS_SS)}; \
        pg8::gemm_phase<EpiA1>(ldsl, C.tid, DM, DM, DM, S, E); } PHASE_END \
    PHASE_BEGIN REP(1) { \
        mixA_phase(C, WSP(bf16_t, WS_RC), WSP(bf16_t, WS_RD), WSP(float, WS_SS), args.in[4] + (size_t)(J) * 8 * 128 * 128, args.in[5] + (size_t)(J) * 8 * 128, args.in[3] + (size_t)(J) * DI, WSP(bf16_t, WS_RE)); } PHASE_END \
    GEMM_OUT(WS_RE, XCUR)

#define LAYER_B(XCUR) \
    PHASE_BEGIN REP(2) { int base = 0; \
        conv_mat(C, args.in[8], 2 * DI, DM, 2 * DI, WSP(bf16_t, WS_WIN), 0, base); \
        conv_mat(C, args.in[10], DM, DI, DM, WSP(bf16_t, WS_WOUT), 0, base); \
        for (int g = 0; g < 8; ++g) conv_mat(C, args.in[9] + (size_t)g * 512 * 512, 512, 512, 512, WSP(bf16_t, WS_WMTB) + (size_t)g * 512 * 512, 0, base); \
        norm_phase(C, XCUR, args.in[7], WSP(bf16_t, WS_RB)); } PHASE_END \
    PHASE_BEGIN { \
        pg8::Sched S{2, 4, 8 * 2 * 4, C.G, C.bid, 1, WSP(bf16_t, WS_WMTB), WSP(bf16_t, WS_CS), (size_t)512 * 512, 0, (size_t)256 * 512, 0, 0, (size_t)256 * 512}; \
        EpiPre E{WSP(bf16_t, WS_WMIX)}; \
        pg8::gemm_phase<EpiPre>(ldsl, C.tid, 512, 512, 512, S, E); } \
        if (ph + 1 < hi) {   } } ++ph; \
    PHASE_BEGIN { \
        pg8::Sched S{64, 32, 64 * 32, C.G, C.bid, 1, WSP(bf16_t, WS_RB), WSP(bf16_t, WS_WIN), 0, 0, (size_t)256 * DM, 0, 0, (size_t)256 * DM}; \
        EpiBC1 E{WSP(bf16_t, WS_RC), WSP(bf16_t, WS_RA)}; \
        pg8::gemm_phase<EpiBC1>(ldsl, C.tid, DM, DM, DM, S, E); } PHASE_END \
    PHASE_BEGIN REP(4) { fft1_phase(C, WSP(bf16_t, WS_RC), WSP(bf16_t, WS_M1), WSP(bf16_t, WS_RD)); } PHASE_END \
    PHASE_BEGIN REP(4) { fft2_phase(C, WSP(bf16_t, WS_RD), WSP(bf16_t, WS_M2), WSP(bf16_t, WS_RB)); } PHASE_END \
    PHASE_BEGIN REP(32) { \
        pg8::Sched S{64, 2, 8 * 64 * 2, C.G, C.bid, 1, WSP(bf16_t, WS_RB), WSP(bf16_t, WS_WMIX), 1024, 0, (size_t)256 * 8192, (size_t)512 * 1024, 0, (size_t)256 * 1024}; \
        EpiGate E{WSP(bf16_t, WS_RD), WSP(bf16_t, WS_RA), nullptr, 6.9053396600248786e-4f, 0, 512}; \
        pg8::gemm_phase<EpiGate>(ldsl, C.tid, 1024, 8192, 1024, S, E); } PHASE_END \
    GEMM_OUT(WS_RD, XCUR)

#define LAYER_C(XCUR) \
    PHASE_BEGIN REP(2) { int base = 0; \
        conv_mat(C, args.in[12] + DI, 2 * DI, DM, DI, WSP(bf16_t, WS_WIN) + (size_t)DI * DM, 0, base); \
        copy_cvt(C, args.in[12], 2 * DI, DM, DI, WSP(bf16_t, WS_WIN) + (size_t)2 * DI * DM); \
        conv_mat(C, args.in[15], DM, DI, DM, WSP(bf16_t, WS_WOUT), 0, base); \
        for (int g = 0; g < 4; ++g) conv_mat(C, args.in[13] + (size_t)g * 1024 * 1024, 1024, 1024, 1024, WSP(bf16_t, WS_WMIX) + (size_t)g * 1024 * 1024, 0, base); \
        norm_phase(C, XCUR, args.in[11], WSP(bf16_t, WS_RB)); } PHASE_END \
    PHASE_BEGIN {   \
        pg8::Sched S{4, 8, 4 * 4 * 8, C.G, C.bid, 1, WSP(bf16_t, WS_WMIX), WSP(bf16_t, WS_WIN) + (size_t)2 * DI * DM, (size_t)1024 * 1024, 0, (size_t)256 * 1024, 1024, 0, (size_t)256 * DI}; \
        EpiW E{WSP(bf16_t, WS_WIN), args.in[14]}; \
        pg8::gemm_phase<EpiW>(ldsl, C.tid, 1024, 1024, DI, S, E); } PHASE_END \
    PHASE_BEGIN REP(16) { \
        pg8::Sched S{64, 32, 64 * 32, C.G, C.bid, 1, WSP(bf16_t, WS_RB), WSP(bf16_t, WS_WIN), 0, 0, (size_t)256 * DM, 0, 0, (size_t)256 * DM}; \
        EpiBC1 E{WSP(bf16_t, WS_RC), WSP(bf16_t, WS_RA)}; \
        pg8::gemm_phase<EpiBC1>(ldsl, C.tid, DM, DM, DM, S, E); } PHASE_END \
    PHASE_BEGIN REP(128) { pool_phase(C, WSP(bf16_t, WS_RC), WSP(bf16_t, WS_RA), WSP(bf16_t, WS_RE)); } PHASE_END \
    GEMM_OUT(WS_RE, XCUR)

__global__ void __launch_bounds__(NTHR, 2) fwd_mega(Args args) {
    extern __shared__ __attribute__((aligned(16))) unsigned char lds_raw[];
    cg::grid_group grid = cg::this_grid();
    int ph = 0; unsigned nbar = 0;
    const int lo = args.ph_lo, hi = args.ph_hi;
    if (blockIdx.x == 0 && threadIdx.x < 64) __hip_atomic_store((unsigned*)(args.ws + WS_BAR) + 64 * threadIdx.x, 0u, __ATOMIC_RELAXED, __HIP_MEMORY_SCOPE_AGENT);
    LAYER_A(0, args.in[0], true)
#if RUN_B
    LAYER_B(args.out)
#endif
#if RUN_C
    LAYER_C(args.out)
#endif
#if RUN_A2
    LAYER_A(1, args.out, false)
#endif
    PHASE_BEGIN { final_norm_phase(C, args.out, args.in[16]); } PHASE_END
}

extern "C" void kernel_launch(void* const* d_in, const int* in_sizes, int n_in, void* d_out, int out_size, void* d_ws, size_t ws_size, hipStream_t stream) {
    static int grid = 0;
    if (grid == 0) {
        if (n_in != 17 || ws_size < WS_END) { fprintf(stderr, "kernel_launch: unexpected n_in %d / ws_size %zu (need %zu)\n", n_in, ws_size, (size_t)WS_END); grid = -1; return; }
        int dev = 0, cus = 0, per_cu = 0;
        hipGetDevice(&dev); hipDeviceGetAttribute(&cus, hipDeviceAttributeMultiprocessorCount, dev);
        if (hipFuncSetAttribute((const void*)fwd_mega, hipFuncAttributeMaxDynamicSharedMemorySize, LDS_BYTES) != hipSuccess) { fprintf(stderr, "kernel_launch: hipFuncSetAttribute failed\n"); grid = -1; return; }
        if (hipOccupancyMaxActiveBlocksPerMultiprocessor(&per_cu, (const void*)fwd_mega, NTHR, LDS_BYTES) != hipSuccess || per_cu < 1) { fprintf(stderr, "kernel_launch: occupancy query says %d\n", per_cu); per_cu = 1; }
        (void)hipGetLastError();
        grid = cus;
        fprintf(stderr, "kernel_launch: grid %d (per_cu %d), ws %zu\n", grid, per_cu, ws_size);
    }
    if (grid < 0) return;
    Args a{};
    for (int i = 0; i < 17; ++i) a.in[i] = (const float*)d_in[i];
    a.out = (float*)d_out; a.ws = (unsigned char*)d_ws;
    hipError_t e = hipSuccess;
#if MULTI_LAUNCH
    for (int p = 0; p < 20 && e == hipSuccess; ++p) { a.ph_lo = p; a.ph_hi = p + 1; void* kargs[] = {&a};
        e = hipLaunchCooperativeKernel((const void*)fwd_mega, dim3(grid), dim3(NTHR), kargs, LDS_BYTES, stream); }
#else
    a.ph_lo = 0; a.ph_hi = 1000;
    void* kargs[] = {&a};
    e = hipLaunchCooperativeKernel((const void*)fwd_mega, dim3(grid), dim3(NTHR), kargs, LDS_BYTES, stream);
#endif
    if (e != hipSuccess) fprintf(stderr, "kernel_launch: cooperative launch failed: %s\n", hipGetErrorString(e));
}
```

```cpp
#include <hip/hip_runtime.h>
#include <hip/hip_cooperative_groups.h>
#include <cstdio>
#include <cstdint>
namespace cg = cooperative_groups;

#define LAS __attribute__((address_space(3)))
typedef unsigned short bf16_t;
typedef short bf16x8 __attribute__((ext_vector_type(8)));
typedef float f32x4 __attribute__((ext_vector_type(4)));
typedef unsigned u32x4 __attribute__((ext_vector_type(4)));
typedef unsigned u32x2 __attribute__((ext_vector_type(2)));

constexpr int MTOK = 16384, DM = 2048, DI = 4096, SEQ = 4096;
constexpr float EPS = 1e-6f;
constexpr size_t MiB = (size_t)1 << 20;
constexpr size_t WS_WIN = 0, WS_WOUT = 48 * MiB, WS_WMIX = 64 * MiB, WS_WMTB = 72 * MiB, WS_CS = 76 * MiB, WS_M1 = 77 * MiB, WS_M2 = 78 * MiB;
constexpr size_t WS_RA = 80 * MiB, WS_RB = 208 * MiB, WS_RC = 336 * MiB, WS_RD = 464 * MiB, WS_RE = 592 * MiB, WS_SS = 720 * MiB, WS_BAR = 724 * MiB, WS_END = 725 * MiB;
constexpr int NTHR = 512;
constexpr int LDS_BYTES = 131072;
#ifndef MULTI_LAUNCH
#define MULTI_LAUNCH 0
#endif
#define RUN_B 1
#define RUN_C 1
#define RUN_A2 1
#ifndef DUP_MASK
#define DUP_MASK 0
#endif
#define REP(bit) for (int rep_ = 0; rep_ < (((DUP_MASK) & (bit)) ? 2 : 1); ++rep_)

typedef float f32x2_t __attribute__((ext_vector_type(2)));
typedef __bf16 bf16x2_t __attribute__((ext_vector_type(2)));
__device__ __forceinline__ unsigned cvt_pk_bf16(float lo, float hi) { const f32x2_t v = {lo, hi}; const bf16x2_t r = __builtin_convertvector(v, bf16x2_t); return __builtin_bit_cast(unsigned, r); }
__device__ __forceinline__ float bf_lo(unsigned w) { return __uint_as_float(w << 16); }
__device__ __forceinline__ float bf_hi(unsigned w) { return __uint_as_float(w & 0xffff0000u); }
__device__ __forceinline__ float gelu_t(float x) {
    const float y = x * (1.0f + 0.044715f * x * x);
    const float e = __builtin_amdgcn_exp2f(-2.0f * 0.7978845608f * 1.4426950409f * y);
    return x * __builtin_amdgcn_rcpf(1.0f + e);
}
__device__ __forceinline__ float silu_f(float x) { const float e = __builtin_amdgcn_exp2f(-1.4426950409f * x); return x * __builtin_amdgcn_rcpf(1.0f + e); }
__device__ __forceinline__ f32x2_t ex2_pk(f32x2_t a) { f32x2_t r; r.x = __builtin_amdgcn_exp2f(a.x); r.y = __builtin_amdgcn_exp2f(a.y); return r; }
__device__ __forceinline__ f32x2_t rcp_pk(f32x2_t a) { f32x2_t r; r.x = __builtin_amdgcn_rcpf(a.x); r.y = __builtin_amdgcn_rcpf(a.y); return r; }
__device__ __forceinline__ f32x2_t gelu_pk(f32x2_t v) { const f32x2_t y = v * (v * v * 0.044715f + 1.0f); return v * rcp_pk(ex2_pk(y * (-2.0f * 0.7978845608f * 1.4426950409f)) + 1.0f); }
__device__ __forceinline__ f32x2_t silu_pk(f32x2_t g) { return g * rcp_pk(ex2_pk(g * (-1.4426950409f)) + 1.0f); }
__device__ __forceinline__ f32x2_t gelu_silu_pk(f32x2_t u, f32x2_t g) {
    const f32x2_t y = u * (u * u * 0.044715f + 1.0f);
    const f32x2_t ea = ex2_pk(y * (-2.0f * 0.7978845608f * 1.4426950409f)), eg = ex2_pk(g * (-1.4426950409f));
    return (u * g) * rcp_pk((ea + 1.0f) * (eg + 1.0f));
}

namespace pg8 {
constexpr int BM = 256, BK = 64, HALF = 128, HTB = HALF * BK * 2, STAGE_BYTES = 8 * HTB, NXCD = 8, WGM = 8;
__host__ __device__ __forceinline__ int lds_byte(int r, int c) { const int st = (r >> 4) * 2 + (c >> 5), rr = r & 15, cc = c & 31, ob = rr * 64 + cc * 2; return st * 1024 + (ob ^ (((ob >> 9) & 1) << 5)); }
__host__ __device__ __forceinline__ void stage_rc(int b, int& R, int& C) { const int st = b / 1024, sb = b % 1024, swz = sb ^ (((sb >> 9) & 1) << 5); R = (st >> 1) * 16 + swz / 64; C = (st & 1) * 32 + (swz % 64) / 2; }
__host__ __device__ __forceinline__ int perm32(int rho) { const int n = rho >> 4, i = rho & 15; return 8 * (i >> 2) + 4 * n + (i & 3); }

struct Unit { const char* a; const char* b; int p, pm, pn; };

struct Sched {
    int nM, nN, nwg, G, c, P2;
    const bf16_t* A; const bf16_t* B;
    size_t sA1, sA2, sAm, sB1, sB2, sBn;
    __device__ __forceinline__ bool next(int i, Unit& u) const {
        const long L = (long)i * G + c; if (L >= nwg) return false;
        int wgid = (int)L; { const int q = nwg / NXCD, r = nwg % NXCD, xcd = wgid % NXCD, off = wgid / NXCD; wgid = (xcd < r ? xcd * (q + 1) : r * (q + 1) + (xcd - r) * q) + off; }
        const int per = nM * nN; const int p = wgid / per, w = wgid % per;
        const int nig = WGM * nN, gid = w / nig, fm = gid * WGM, gsz = (nM - fm) < WGM ? (nM - fm) : WGM;
        u.p = p; u.pm = fm + ((w % nig) % gsz); u.pn = (w % nig) / gsz;
        const int p1 = p / P2, p2 = p % P2;
        u.a = (const char*)(A + (size_t)p1 * sA1 + (size_t)p2 * sA2 + (size_t)u.pm * sAm);
        u.b = (const char*)(B + (size_t)p1 * sB1 + (size_t)p2 * sB2 + (size_t)u.pn * sBn);
        return true;
    }
};

template <class Epi>
__device__ __forceinline__ void gemm_phase(LAS unsigned char* lds, const int tid, const int K, const int lda, const int ldb, const Sched& S, const Epi& E) {
    const int wid = __builtin_amdgcn_readfirstlane(tid >> 6), lane = tid & 63, wr = wid >> 2, wc = wid & 3, fr = lane & 15, fq = lane >> 4;
    const int nt = K / BK;
    unsigned voffA[2], voffB[2];
#pragma unroll
    for (int i = 0; i < 2; ++i) { int R, C; stage_rc(tid * 16 + i * 8192, R, C); const int Rb = Epi::PERM ? ((R & ~31) + perm32(R & 31)) : R;
        voffA[i] = (unsigned)(R * lda + C) * 2u; voffB[i] = (unsigned)(Rb * ldb + C) * 2u; }
    const size_t kstep = (size_t)(BK * 2);
    const size_t hstepA = (size_t)HALF * lda * 2, hstepB = (size_t)HALF * ldb * 2;
    const unsigned ldsw = (unsigned)wid * 1024u;
    const int aoff = lds_byte(wr * 64 + fr, fq * 8), boff = lds_byte(wc * 32 + fr, fq * 8);
#define PG8_SA(b, h) (((b) * 2 + (h)) * HTB)
#define PG8_SB(b, h) ((4 + (b) * 2 + (h)) * HTB)
#define PG8_STAGE(bufoff, gbase, voff) do { _Pragma("unroll") for (int _i = 0; _i < 2; ++_i) \
        __builtin_amdgcn_global_load_lds((const unsigned*)((const char*)(gbase) + (voff)[_i]), (LAS unsigned*)(lds + (bufoff) + ldsw + _i * 8192), 16, 0, 0); } while (0)
#define PG8_LDA(dst, b, h) do { _Pragma("unroll") for (int m = 0; m < 4; ++m) _Pragma("unroll") for (int k = 0; k < 2; ++k) dst[m][k] = *(const LAS bf16x8*)(lds + PG8_SA(b, h) + aoff + m * 2048 + k * 1024); } while (0)
#define PG8_LDB(dst, b, h) do { _Pragma("unroll") for (int n = 0; n < 2; ++n) _Pragma("unroll") for (int k = 0; k < 2; ++k) dst[n][k] = *(const LAS bf16x8*)(lds + PG8_SB(b, h) + boff + n * 2048 + k * 1024); } while (0)
#define PG8_MMA(ai, bj, At, Bt) do { __builtin_amdgcn_s_setprio(1); _Pragma("unroll") for (int m = 0; m < 4; ++m) _Pragma("unroll") for (int n = 0; n < 2; ++n) _Pragma("unroll") for (int k = 0; k < 2; ++k) \
        acc[ai][bj][m][n] = __builtin_amdgcn_mfma_f32_16x16x32_bf16(Bt[n][k], At[m][k], acc[ai][bj][m][n], 0, 0, 0); __builtin_amdgcn_s_setprio(0); } while (0)
#define PG8_WAIT_V(n) asm volatile("s_waitcnt vmcnt(" #n ")" ::: "memory")
#define PG8_WAIT_L(n) asm volatile("s_waitcnt lgkmcnt(" #n ")" ::: "memory")
#define PG8_BAR __builtin_amdgcn_s_barrier()
#define PG8_SCHED __builtin_amdgcn_sched_barrier(0)
    Unit cur, nxt; int ui = 0;
    if (!S.next(0, cur)) return;
    f32x4 acc[2][2][4][2];
#pragma unroll
    for (int a = 0; a < 2; ++a)
#pragma unroll
        for (int b = 0; b < 2; ++b)
#pragma unroll
            for (int m = 0; m < 4; ++m)
#pragma unroll
                for (int n = 0; n < 2; ++n) acc[a][b][m][n] = (f32x4){0.f, 0.f, 0.f, 0.f};
    bf16x8 At[4][2], B0[2][2], B1[2][2];
    const char* cA = cur.a; const char* cB = cur.b;
    PG8_STAGE(PG8_SB(0, 0), cB, voffB); PG8_STAGE(PG8_SB(0, 1), cB + hstepB, voffB); PG8_STAGE(PG8_SA(0, 0), cA, voffA); PG8_STAGE(PG8_SA(0, 1), cA + hstepA, voffA);
    if (wr == 1) PG8_BAR;
    PG8_WAIT_V(2); PG8_BAR;
    PG8_STAGE(PG8_SB(1, 0), cB + kstep, voffB); PG8_STAGE(PG8_SA(1, 0), cA + kstep, voffA); PG8_STAGE(PG8_SB(1, 1), cB + hstepB + kstep, voffB);
    PG8_WAIT_V(6); PG8_BAR;
    for (;;) {
        const bool has_next = S.next(ui + 1, nxt);
        const char* nA = has_next ? nxt.a : cA; const char* nB = has_next ? nxt.b : cB;
        for (int t = 0; t < nt; t += 2) {
            const bool last = (t == nt - 2);
            const char* a1 = cA + (size_t)(t + 1) * kstep;
            const char* a2 = last ? nA : cA + (size_t)(t + 2) * kstep; const char* b2 = last ? nB : cB + (size_t)(t + 2) * kstep;
            const char* a3 = a2 + kstep; const char* b3 = b2 + kstep;
            PG8_LDB(B0, 0, 0); PG8_LDB(B1, 0, 1); PG8_SCHED; PG8_LDA(At, 0, 0); PG8_STAGE(PG8_SA(1, 1), a1 + hstepA, voffA);
            PG8_WAIT_V(8); PG8_WAIT_L(0); PG8_BAR; PG8_MMA(0, 0, At, B0); PG8_MMA(0, 1, At, B1); PG8_BAR; PG8_SCHED;
            PG8_LDA(At, 0, 1); PG8_STAGE(PG8_SB(0, 0), b2, voffB); PG8_STAGE(PG8_SB(0, 1), b2 + hstepB, voffB); PG8_STAGE(PG8_SA(0, 0), a2, voffA);
            PG8_WAIT_V(8); PG8_WAIT_L(0); PG8_BAR; PG8_MMA(1, 0, At, B0); PG8_MMA(1, 1, At, B1); PG8_BAR; PG8_SCHED;
            PG8_LDB(B0, 1, 0); PG8_LDB(B1, 1, 1); PG8_SCHED; PG8_LDA(At, 1, 0); PG8_STAGE(PG8_SA(0, 1), a2 + hstepA, voffA);
            PG8_WAIT_V(8); PG8_WAIT_L(0); PG8_BAR; PG8_MMA(0, 0, At, B0); PG8_MMA(0, 1, At, B1); PG8_BAR; PG8_SCHED;
            PG8_LDA(At, 1, 1); PG8_STAGE(PG8_SB(1, 0), b3, voffB); PG8_STAGE(PG8_SB(1, 1), b3 + hstepB, voffB); PG8_STAGE(PG8_SA(1, 0), a3, voffA);
            PG8_WAIT_V(8); PG8_WAIT_L(0); PG8_BAR; PG8_MMA(1, 0, At, B0); PG8_MMA(1, 1, At, B1); PG8_BAR; PG8_SCHED;
        }
        if (wr == 0) PG8_BAR;
        E(acc, cur, wr, wc, fr, fq);
        if (!has_next) break;
#pragma unroll
        for (int a = 0; a < 2; ++a)
#pragma unroll
            for (int b = 0; b < 2; ++b)
#pragma unroll
                for (int m = 0; m < 4; ++m)
#pragma unroll
                    for (int n = 0; n < 2; ++n) acc[a][b][m][n] = (f32x4){0.f, 0.f, 0.f, 0.f};
        cur = nxt; cA = nA; cB = nB; ++ui;
        if (wr == 1) PG8_BAR;
    }
    PG8_WAIT_V(0);
    PG8_BAR;
#undef PG8_SA
#undef PG8_SB
#undef PG8_STAGE
#undef PG8_LDA
#undef PG8_LDB
#undef PG8_MMA
#undef PG8_WAIT_V
#undef PG8_WAIT_L
#undef PG8_BAR
#undef PG8_SCHED
}
}

typedef f32x4 AccT[2][2][4][2];

struct EpiA1 {
    static constexpr bool PERM = true;
    bf16_t* ug; bf16_t* gv; float* sumsq;
    __device__ __forceinline__ void operator()(const AccT& acc, const pg8::Unit& u, int wr, int wc, int fr, int fq) const {
        const int row0 = u.pm * 256 + wr * 64 + fr;
        if (u.pn < 32) {
            const int ch0 = u.pn * 128 + wc * 32 + 8 * fq;
#pragma unroll
            for (int ai = 0; ai < 2; ++ai)
#pragma unroll
                for (int m = 0; m < 4; ++m) {
                    const f32x4 U0 = acc[ai][0][m][0], U1 = acc[ai][0][m][1], G0 = acc[ai][1][m][0], G1 = acc[ai][1][m][1];
                    const f32x2_t r0 = gelu_silu_pk((f32x2_t){U0[0], U0[1]}, (f32x2_t){G0[0], G0[1]}), r1 = gelu_silu_pk((f32x2_t){U0[2], U0[3]}, (f32x2_t){G0[2], G0[3]});
                    const f32x2_t r2 = gelu_silu_pk((f32x2_t){U1[0], U1[1]}, (f32x2_t){G1[0], G1[1]}), r3 = gelu_silu_pk((f32x2_t){U1[2], U1[3]}, (f32x2_t){G1[2], G1[3]});
                    u32x4 w; w.x = cvt_pk_bf16(r0.x, r0.y); w.y = cvt_pk_bf16(r1.x, r1.y); w.z = cvt_pk_bf16(r2.x, r2.y); w.w = cvt_pk_bf16(r3.x, r3.y);
                    *(u32x4*)(ug + (size_t)(row0 + ai * 128 + m * 16) * DI + ch0) = w;
                }
        } else {
            const int chb = (u.pn - 32) * 256 + wc * 32 + 8 * fq;
#pragma unroll
            for (int ai = 0; ai < 2; ++ai)
#pragma unroll
                for (int m = 0; m < 4; ++m) {
                    const int row = row0 + ai * 128 + m * 16; float ss = 0.f;
#pragma unroll
                    for (int bj = 0; bj < 2; ++bj) {
                        const f32x4 a0 = acc[ai][bj][m][0], a1 = acc[ai][bj][m][1];
                        const f32x2_t r0 = gelu_pk((f32x2_t){a0[0], a0[1]}), r1 = gelu_pk((f32x2_t){a0[2], a0[3]}), r2 = gelu_pk((f32x2_t){a1[0], a1[1]}), r3 = gelu_pk((f32x2_t){a1[2], a1[3]});
                        const f32x2_t q = (r0 * r0 + r1 * r1) + (r2 * r2 + r3 * r3); ss += q.x + q.y;
                        u32x4 w; w.x = cvt_pk_bf16(r0.x, r0.y); w.y = cvt_pk_bf16(r1.x, r1.y); w.z = cvt_pk_bf16(r2.x, r2.y); w.w = cvt_pk_bf16(r3.x, r3.y);
                        *(u32x4*)(gv + (size_t)row * DI + chb + bj * 128) = w;
                    }
                    ss += __shfl_xor(ss, 16); ss += __shfl_xor(ss, 32);
                    if (fq == 0) sumsq[(size_t)((u.pn - 32) * 4 + wc) * MTOK + row] = ss;
                }
        }
    }
};
struct EpiBC1 {
    static constexpr bool PERM = true;
    bf16_t* br; bf16_t* sg;
    __device__ __forceinline__ void operator()(const AccT& acc, const pg8::Unit& u, int wr, int wc, int fr, int fq) const {
        const int row0 = u.pm * 256 + wr * 64 + fr;
        const bool gate = u.pn >= 16;
        bf16_t* dst = gate ? sg : br;
        const int col0 = (gate ? u.pn - 16 : u.pn) * 256 + wc * 32 + 8 * fq;
#pragma unroll
        for (int ai = 0; ai < 2; ++ai)
#pragma unroll
            for (int m = 0; m < 4; ++m)
#pragma unroll
                for (int bj = 0; bj < 2; ++bj) {
                    f32x4 v0 = acc[ai][bj][m][0], v1 = acc[ai][bj][m][1];
                    if (gate) {
                        const f32x2_t r0 = silu_pk((f32x2_t){v0[0], v0[1]}), r1 = silu_pk((f32x2_t){v0[2], v0[3]}), r2 = silu_pk((f32x2_t){v1[0], v1[1]}), r3 = silu_pk((f32x2_t){v1[2], v1[3]});
                        v0 = (f32x4){r0.x, r0.y, r1.x, r1.y}; v1 = (f32x4){r2.x, r2.y, r3.x, r3.y};
                    }
                    u32x4 w; w.x = cvt_pk_bf16(v0[0], v0[1]); w.y = cvt_pk_bf16(v0[2], v0[3]); w.z = cvt_pk_bf16(v1[0], v1[1]); w.w = cvt_pk_bf16(v1[2], v1[3]);
                    *(u32x4*)(dst + (size_t)(row0 + ai * 128 + m * 16) * DI + col0 + bj * 128) = w;
                }
    }
};
struct EpiPre {
    static constexpr bool PERM = true;
    bf16_t* bt2;
    __device__ __forceinline__ void operator()(const AccT& acc, const pg8::Unit& u, int wr, int wc, int fr, int fq) const {
        const int g = u.p;
        const int d0 = u.pm * 256 + wr * 64 + fr, c0 = u.pn * 256 + wc * 32 + 8 * fq;
#pragma unroll
        for (int ai = 0; ai < 2; ++ai)
#pragma unroll
            for (int m = 0; m < 4; ++m)
#pragma unroll
                for (int bj = 0; bj < 2; ++bj) {
                    const f32x4 v0 = acc[ai][bj][m][0], v1 = acc[ai][bj][m][1];
                    u32x4 w; w.x = cvt_pk_bf16(v0[0], v0[1]); w.y = cvt_pk_bf16(v0[2], v0[3]); w.z = cvt_pk_bf16(v1[0], v1[1]); w.w = cvt_pk_bf16(v1[2], v1[3]);
                    *(u32x4*)(bt2 + ((size_t)(g * 512 + d0 + ai * 128 + m * 16)) * 1024 + c0 + bj * 128) = w;
                }
    }
};
struct EpiW {
    static constexpr bool PERM = true;
    bf16_t* w; const float* cscale;
    __device__ __forceinline__ void operator()(const AccT& acc, const pg8::Unit& u, int wr, int wc, int fr, int fq) const {
        const int row0 = u.p * 1024 + u.pm * 256 + wr * 64 + fr, col0 = u.pn * 256 + wc * 32 + 8 * fq;
#pragma unroll
        for (int ai = 0; ai < 2; ++ai)
#pragma unroll
            for (int m = 0; m < 4; ++m) {
                const int row = row0 + ai * 128 + m * 16; const float sc = cscale[row];
#pragma unroll
                for (int bj = 0; bj < 2; ++bj) {
                    const f32x4 v0 = acc[ai][bj][m][0] * sc, v1 = acc[ai][bj][m][1] * sc;
                    u32x4 q; q.x = cvt_pk_bf16(v0[0], v0[1]); q.y = cvt_pk_bf16(v0[2], v0[3]); q.z = cvt_pk_bf16(v1[0], v1[1]); q.w = cvt_pk_bf16(v1[2], v1[3]);
                    *(u32x4*)(w + (size_t)row * DM + col0 + bj * 128) = q;
                }
            }
    }
};
struct EpiGate {
    static constexpr bool PERM = true;
    bf16_t* t; const bf16_t* sg; const float* cscale; float sc; int rowsPerP, colsPerP;
    __device__ __forceinline__ void operator()(const AccT& acc, const pg8::Unit& u, int wr, int wc, int fr, int fq) const {
        const int row0 = u.p * rowsPerP + u.pm * 256 + wr * 64 + fr, col0 = u.p * colsPerP + u.pn * 256 + wc * 32 + 8 * fq;
        u32x4 gq[2][4][2];
#pragma unroll
        for (int ai = 0; ai < 2; ++ai)
#pragma unroll
            for (int m = 0; m < 4; ++m)
#pragma unroll
                for (int bj = 0; bj < 2; ++bj) gq[ai][m][bj] = *(const u32x4*)(sg + (size_t)(row0 + ai * 128 + m * 16) * DI + col0 + bj * 128);
        f32x4 s0[2], s1[2];
#pragma unroll
        for (int bj = 0; bj < 2; ++bj) {
            if (cscale) { s0[bj] = *(const f32x4*)(cscale + col0 + bj * 128); s1[bj] = *(const f32x4*)(cscale + col0 + bj * 128 + 4); }
            else { s0[bj] = (f32x4){sc, sc, sc, sc}; s1[bj] = s0[bj]; }
        }
#pragma unroll
        for (int ai = 0; ai < 2; ++ai)
#pragma unroll
            for (int m = 0; m < 4; ++m)
#pragma unroll
                for (int bj = 0; bj < 2; ++bj) {
                    const size_t off = (size_t)(row0 + ai * 128 + m * 16) * DI + col0 + bj * 128;
                    const u32x4 g = gq[ai][m][bj];
                    const f32x4 v0 = acc[ai][bj][m][0] * s0[bj], v1 = acc[ai][bj][m][1] * s1[bj];
                    u32x4 w;
                    w.x = cvt_pk_bf16(v0[0] * bf_lo(g.x), v0[1] * bf_hi(g.x)); w.y = cvt_pk_bf16(v0[2] * bf_lo(g.y), v0[3] * bf_hi(g.y));
                    w.z = cvt_pk_bf16(v1[0] * bf_lo(g.z), v1[1] * bf_hi(g.z)); w.w = cvt_pk_bf16(v1[2] * bf_lo(g.w), v1[3] * bf_hi(g.w));
                    *(u32x4*)(t + off) = w;
                }
    }
};
struct EpiOut {
    static constexpr bool PERM = false;
    const float* xold; float* xnew;
    __device__ __forceinline__ void operator()(const AccT& acc, const pg8::Unit& u, int wr, int wc, int fr, int fq) const {
        const int row0 = u.pm * 256 + wr * 64 + fr, col0 = u.pn * 256 + wc * 32 + 4 * fq;
#pragma unroll
        for (int ai = 0; ai < 2; ++ai) {
            f32x4 o[4][2][2];
#pragma unroll
            for (int m = 0; m < 4; ++m)
#pragma unroll
                for (int bj = 0; bj < 2; ++bj)
#pragma unroll
                    for (int n = 0; n < 2; ++n) o[m][bj][n] = *(const f32x4*)(xold + (size_t)(row0 + ai * 128 + m * 16) * DM + col0 + bj * 128 + n * 16);
            asm volatile("" ::: "memory");
#pragma unroll
            for (int m = 0; m < 4; ++m)
#pragma unroll
                for (int bj = 0; bj < 2; ++bj)
#pragma unroll
                    for (int n = 0; n < 2; ++n) *(f32x4*)(xnew + (size_t)(row0 + ai * 128 + m * 16) * DM + col0 + bj * 128 + n * 16) = o[m][bj][n] + acc[ai][bj][m][n];
            asm volatile("" ::: "memory");
        }
    }
};

struct Ctx { int tid, lane, wave, G, bid; unsigned char* lds; };

__device__ __forceinline__ void conv_tile(const Ctx& C, const float* src, int ldsrc, int k0, int c0, bf16_t* dst, int ldd, int n0) {
    float* T = (float*)C.lds;
    const int kk = C.tid >> 4, c4 = (C.tid & 15) * 4;
#pragma unroll
    for (int i = 0; i < 2; ++i) {
        const int k = kk + 32 * i;
        const f32x4 v = *(const f32x4*)(src + (size_t)(k0 + k) * ldsrc + c0 + c4);
        T[k * 65 + c4 + 0] = v[0]; T[k * 65 + c4 + 1] = v[1]; T[k * 65 + c4 + 2] = v[2]; T[k * 65 + c4 + 3] = v[3];
    }
    __syncthreads();
    const int n = C.tid >> 3, k8 = (C.tid & 7) * 8;
    u32x4 w;
    w.x = cvt_pk_bf16(T[(k8 + 0) * 65 + n], T[(k8 + 1) * 65 + n]); w.y = cvt_pk_bf16(T[(k8 + 2) * 65 + n], T[(k8 + 3) * 65 + n]);
    w.z = cvt_pk_bf16(T[(k8 + 4) * 65 + n], T[(k8 + 5) * 65 + n]); w.w = cvt_pk_bf16(T[(k8 + 6) * 65 + n], T[(k8 + 7) * 65 + n]);
    *(u32x4*)(dst + (size_t)(n0 + n) * ldd + k0 + k8) = w;
    __syncthreads();
}
__device__ __forceinline__ void copy_cvt(const Ctx& C, const float* src, int ldsrc, int rows, int ncols, bf16_t* dst) {
    const int per = ncols / 8, total = rows * per;
    for (int i = C.bid * NTHR + C.tid; i < total; i += C.G * NTHR) {
        const int r = i / per, c = (i % per) * 8;
        const f32x4 a = *(const f32x4*)(src + (size_t)r * ldsrc + c), b = *(const f32x4*)(src + (size_t)r * ldsrc + c + 4);
        u32x4 w; w.x = cvt_pk_bf16(a[0], a[1]); w.y = cvt_pk_bf16(a[2], a[3]); w.z = cvt_pk_bf16(b[0], b[1]); w.w = cvt_pk_bf16(b[2], b[3]);
        *(u32x4*)(dst + (size_t)r * ncols + c) = w;
    }
}
__device__ __forceinline__ void conv_mat(const Ctx& C, const float* src, int ldsrc, int K, int Nd, bf16_t* dst, int mode, int& base) {
    const int tk = K / 64, tn = Nd / 64, ntile = tk * tn;
    int start = (C.bid - (base % C.G) + C.G) % C.G;
    for (int t = start; t < ntile; t += C.G) {
        const int in_ = t / tk, ik = t % tk;
        const int n0 = in_ * 64;
        int c0 = n0;
        if (mode == 1) {
            if (n0 < 8192) { const int tile = n0 >> 8, r = n0 & 255; c0 = (r < 128) ? tile * 128 + r : 8192 + tile * 128 + (r - 128); }
            else c0 = 4096 + (n0 - 8192);
        }
        conv_tile(C, src, ldsrc, ik * 64, c0, dst, K, n0);
    }
    base += ntile;
}
__device__ __forceinline__ void norm_phase(const Ctx& C, const float* x, const float* gain, bf16_t* h) {
    for (int row = C.bid * 8 + C.wave; row < MTOK; row += C.G * 8) {
        const float* xr = x + (size_t)row * DM;
        f32x4 v[8]; float ss = 0.f;
#pragma unroll
        for (int j = 0; j < 4; ++j) {
            v[2 * j] = *(const f32x4*)(xr + (j * 64 + C.lane) * 8); v[2 * j + 1] = *(const f32x4*)(xr + (j * 64 + C.lane) * 8 + 4);
#pragma unroll
            for (int e = 0; e < 4; ++e) ss += v[2 * j][e] * v[2 * j][e] + v[2 * j + 1][e] * v[2 * j + 1][e];
        }
#pragma unroll
        for (int o = 1; o < 64; o <<= 1) ss += __shfl_xor(ss, o);
        const float rs = __builtin_amdgcn_rsqf(ss * (1.0f / DM) + EPS);
#pragma unroll
        for (int j = 0; j < 4; ++j) {
            const int c = (j * 64 + C.lane) * 8;
            const f32x4 g0 = *(const f32x4*)(gain + c), g1 = *(const f32x4*)(gain + c + 4);
            const f32x4 a = v[2 * j] * rs * g0, b = v[2 * j + 1] * rs * g1;
            u32x4 w; w.x = cvt_pk_bf16(a[0], a[1]); w.y = cvt_pk_bf16(a[2], a[3]); w.z = cvt_pk_bf16(b[0], b[1]); w.w = cvt_pk_bf16(b[2], b[3]);
            *(u32x4*)(h + (size_t)row * DM + c) = w;
        }
    }
}
__device__ __forceinline__ void final_norm_phase(const Ctx& C, float* x, const float* gain) {
    for (int row = C.bid * 8 + C.wave; row < MTOK; row += C.G * 8) {
        float* xr = x + (size_t)row * DM;
        f32x4 v[8]; float ss = 0.f;
#pragma unroll
        for (int j = 0; j < 8; ++j) {
            v[j] = *(const f32x4*)(xr + (j * 64 + C.lane) * 4);
#pragma unroll
            for (int e = 0; e < 4; ++e) ss += v[j][e] * v[j][e];
        }
#pragma unroll
        for (int o = 1; o < 64; o <<= 1) ss += __shfl_xor(ss, o);
        const float rs = __builtin_amdgcn_rsqf(ss * (1.0f / DM) + EPS);
#pragma unroll
        for (int j = 0; j < 8; ++j) {
            const int c = (j * 64 + C.lane) * 4;
            const f32x4 g0 = *(const f32x4*)(gain + c);
            *(f32x4*)(xr + c) = v[j] * rs * g0;
        }
    }
}
__device__ __forceinline__ void gen_tables(const Ctx& C, bf16_t* cs, bf16_t* m1, bf16_t* m2) {
    const int gt = C.bid * NTHR + C.tid, GT = C.G * NTHR;
    for (int i = gt; i < 1024 * 512 / 8; i += GT) {
        const int n = i / 64, d0 = (i % 64) * 8; const int c = n & 511; const bool sn = n >= 512;
        float v[8];
#pragma unroll
        for (int e = 0; e < 8; ++e) { const float rev = (float)((c * (d0 + e)) & 511) * (1.0f / 512.0f); v[e] = sn ? __builtin_amdgcn_sinf(rev) : __builtin_amdgcn_cosf(rev); }
        u32x4 w; w.x = cvt_pk_bf16(v[0], v[1]); w.y = cvt_pk_bf16(v[2], v[3]); w.z = cvt_pk_bf16(v[4], v[5]); w.w = cvt_pk_bf16(v[6], v[7]);
        *(u32x4*)(cs + (size_t)i * 8) = w;
    }
    for (int i = gt; i < 64 * 128 * 64 / 8; i += GT) {
        const int s2 = i >> 10, r = (i >> 3) & 127, s10 = (i & 7) * 8; const int k1 = r & 63; const bool sn = r >= 64;
        float v[8];
#pragma unroll
        for (int e = 0; e < 8; ++e) { const float rev = (float)(((64 * (s10 + e) + s2) * k1) & 4095) * (1.0f / 4096.0f); v[e] = sn ? __builtin_amdgcn_sinf(rev) : __builtin_amdgcn_cosf(rev); }
        u32x4 w; w.x = cvt_pk_bf16(v[0], v[1]); w.y = cvt_pk_bf16(v[2], v[3]); w.z = cvt_pk_bf16(v[4], v[5]); w.w = cvt_pk_bf16(v[6], v[7]);
        *(u32x4*)(m1 + (size_t)i * 8) = w;
    }
    for (int i = gt; i < 128 * 128 / 8; i += GT) {
        const int r = i >> 4, c0 = (i & 15) * 8; const int k2 = r & 63; const bool rim = r >= 64;
        float v[8];
#pragma unroll
        for (int e = 0; e < 8; ++e) { const int c = c0 + e, s2 = c & 63; const bool cim = c >= 64; const float rev = (float)((s2 * k2) & 63) * (1.0f / 64.0f);
            const float cs_ = __builtin_amdgcn_cosf(rev), sn_ = __builtin_amdgcn_sinf(rev);
            v[e] = rim ? (cim ? -cs_ : -sn_) : (cim ? -sn_ : cs_); }
        u32x4 w; w.x = cvt_pk_bf16(v[0], v[1]); w.y = cvt_pk_bf16(v[2], v[3]); w.z = cvt_pk_bf16(v[4], v[5]); w.w = cvt_pk_bf16(v[6], v[7]);
        *(u32x4*)(m2 + (size_t)i * 8) = w;
    }
}
typedef short s16x4 __attribute__((ext_vector_type(4)));
constexpr int SK_PITCH = 144, SK_AUX_OFF = 34816, SK_SLAB_OFF = 37376, SK_SLAB_BYTES = 128 * SK_PITCH;
struct SkItem { const bf16_t* in; size_t in_stride; bf16_t* out; const bf16_t* mul; const float* vg; const float* bs; };
template <int MODE> __device__ __forceinline__ size_t sk_out_off(int r) {
    if (MODE == 0) return (size_t)r * DI;
    if (MODE == 1) return (size_t)((r & 63) * 128 + (r >> 6) * 64) * DI;
    return (size_t)(r & 63) * 64 * 8192 + (size_t)(r >> 6) * 512;
}
template <int MODE, int KQ>
__device__ __forceinline__ void sk_core(const Ctx& C, LAS unsigned char* L, const SkItem& it) {
    constexpr int MP = (KQ + 8) * 2;
    const int pair = C.wave >> 1, hw = C.wave & 1, lp = hw * 64 + C.lane;
    const int fr = C.lane & 15, fq = C.lane >> 4, trq = (C.lane & 15) >> 2, trp = C.lane & 3;
    LAS unsigned char* slab = L + SK_SLAB_OFF + pair * SK_SLAB_BYTES;
    __syncthreads();
    {
        u32x4 v[KQ / 16];
#pragma unroll
        for (int i = 0; i < KQ / 16; ++i) v[i] = *(const u32x4*)(it.in + (size_t)((lp >> 3) + 16 * i) * it.in_stride + pair * 64 + (lp & 7) * 8);
#pragma unroll
        for (int i = 0; i < KQ / 16; ++i) *(LAS u32x4*)(slab + ((lp >> 3) + 16 * i) * SK_PITCH + (lp & 7) * 16) = v[i];
    }
    __syncthreads();
    f32x4 acc[4][4];
#pragma unroll
    for (int cb = 0; cb < 4; ++cb)
#pragma unroll
        for (int pb = 0; pb < 4; ++pb) acc[cb][pb] = (f32x4){0.f, 0.f, 0.f, 0.f};
#pragma unroll
    for (int kb = 0; kb < KQ / 32; ++kb) {
        bf16x8 af[4];
#pragma unroll
        for (int cb = 0; cb < 4; ++cb) {
            const s16x4 t0 = __builtin_amdgcn_ds_read_tr16_b64_v4i16((LAS s16x4*)(slab + (32 * kb + 8 * fq + trq) * SK_PITCH + (16 * cb + 4 * trp) * 2));
            const s16x4 t1 = __builtin_amdgcn_ds_read_tr16_b64_v4i16((LAS s16x4*)(slab + (32 * kb + 8 * fq + 4 + trq) * SK_PITCH + (16 * cb + 4 * trp) * 2));
            af[cb] = (bf16x8){t0[0], t0[1], t0[2], t0[3], t1[0], t1[1], t1[2], t1[3]};
        }
#pragma unroll
        for (int pb = 0; pb < 4; ++pb) {
            const bf16x8 bfr = *(const LAS bf16x8*)(L + (64 * hw + pb * 16 + fr) * MP + (kb * 32 + fq * 8) * 2);
#pragma unroll
            for (int cb = 0; cb < 4; ++cb) acc[cb][pb] = __builtin_amdgcn_mfma_f32_16x16x32_bf16(af[cb], bfr, acc[cb][pb], 0, 0, 0);
        }
    }
    __syncthreads();
#pragma unroll
    for (int cb = 0; cb < 4; ++cb) {
        f32x4 vg = (f32x4){1.f, 1.f, 1.f, 1.f};
        if (MODE == 0) vg = *(const f32x4*)(it.vg + pair * 64 + cb * 16 + 4 * fq);
#pragma unroll
        for (int pb = 0; pb < 4; ++pb) {
            const int row = 64 * hw + pb * 16 + fr;
            f32x4 v = acc[cb][pb];
            if (MODE == 0) v = v * vg + it.bs[row];
            u32x2 w; w.x = cvt_pk_bf16(v[0], v[1]); w.y = cvt_pk_bf16(v[2], v[3]);
            *(LAS u32x2*)(slab + row * SK_PITCH + (cb * 16 + 4 * fq) * 2) = w;
        }
    }
    u32x4 mv[8];
    if (MODE == 0) {
#pragma unroll
        for (int i = 0; i < 8; ++i) mv[i] = *(const u32x4*)(it.mul + (size_t)(64 * hw + i * 8 + (C.lane >> 3)) * DI + pair * 64 + (C.lane & 7) * 8);
    }
#pragma unroll
    for (int i = 0; i < 8; ++i) {
        const int row = 64 * hw + i * 8 + (C.lane >> 3);
        u32x4 sv = *(const LAS u32x4*)(slab + row * SK_PITCH + (C.lane & 7) * 16);
        if (MODE == 0) {
            const u32x4 m = mv[i];
            sv.x = cvt_pk_bf16(bf_lo(sv.x) * bf_lo(m.x), bf_hi(sv.x) * bf_hi(m.x)); sv.y = cvt_pk_bf16(bf_lo(sv.y) * bf_lo(m.y), bf_hi(sv.y) * bf_hi(m.y));
            sv.z = cvt_pk_bf16(bf_lo(sv.z) * bf_lo(m.z), bf_hi(sv.z) * bf_hi(m.z)); sv.w = cvt_pk_bf16(bf_lo(sv.w) * bf_lo(m.w), bf_hi(sv.w) * bf_hi(m.w));
        }
        *(u32x4*)(it.out + sk_out_off<MODE>(row) + pair * 64 + (C.lane & 7) * 8) = sv;
    }
}
__device__ __forceinline__ void mixA_phase(const Ctx& C, const bf16_t* ug, const bf16_t* gv, const float* sumsq, const float* w_s, const float* b_s, const float* v_gain, bf16_t* t) {
    constexpr int WP = 136;
    LAS unsigned char* L = (LAS unsigned char*)C.lds;
    float* rstd = (float*)(C.lds + SK_AUX_OFF);
    float* red = (float*)(C.lds + SK_AUX_OFF + 512);
    bf16_t* Wl = (bf16_t*)C.lds;
    for (int item = C.bid; item < 1024; item += C.G) {
        const int g = item & 7, n = item >> 3;
        __syncthreads();
        {
            const int r = C.tid & 127, part = C.tid >> 7; float a = 0.f;
#pragma unroll
            for (int i = 0; i < 16; ++i) a += sumsq[(size_t)(part * 16 + i) * MTOK + n * 128 + r];
            red[part * 128 + r] = a;
            __syncthreads();
            if (C.tid < 128) rstd[C.tid] = __builtin_amdgcn_rsqf(((red[C.tid] + red[128 + C.tid]) + (red[256 + C.tid] + red[384 + C.tid])) * (1.0f / DI) + EPS);
        }
        __syncthreads();
        {
            const int p = C.tid >> 2, q0 = (C.tid & 3) * 32;
            const float* wsrc = w_s + ((size_t)g * 128 + p) * 128 + q0;
#pragma unroll
            for (int j = 0; j < 4; ++j) {
                const f32x4 a = *(const f32x4*)(wsrc + j * 8), b = *(const f32x4*)(wsrc + j * 8 + 4);
                const int q = q0 + j * 8;
                u32x4 w;
                w.x = cvt_pk_bf16(a[0] * rstd[q + 0], a[1] * rstd[q + 1]); w.y = cvt_pk_bf16(a[2] * rstd[q + 2], a[3] * rstd[q + 3]);
                w.z = cvt_pk_bf16(b[0] * rstd[q + 4], b[1] * rstd[q + 5]); w.w = cvt_pk_bf16(b[2] * rstd[q + 6], b[3] * rstd[q + 7]);
                *(u32x4*)(Wl + p * WP + q) = w;
            }
        }
        const size_t off0 = (size_t)n * 128 * DI + g * 512;
#pragma unroll 1
        for (int h = 0; h < 2; ++h) {
            SkItem it{gv + off0 + h * 256, (size_t)DI, t + off0 + h * 256, ug + off0 + h * 256, v_gain + g * 512 + h * 256, b_s + g * 128};
            sk_core<0, 128>(C, L, it);
        }
    }
}
__device__ __forceinline__ void fft1_phase(const Ctx& C, const bf16_t* xb, const bf16_t* m1, bf16_t* ap) {
    LAS unsigned char* L = (LAS unsigned char*)C.lds;
    for (int w = C.bid; w < 256; w += C.G) {
        const int s2 = w >> 2, sub = w & 3;
        __syncthreads();
#pragma unroll
        for (int i = 0; i < 2; ++i) { const int idx = C.tid * 8 + i * 4096, r = idx >> 6, c = idx & 63;
            *(LAS u32x4*)(L + r * 144 + c * 2) = *(const u32x4*)(m1 + (size_t)s2 * 8192 + idx); }
#pragma unroll 1
        for (int j = 0; j < 16; ++j) {
            const int combo = sub * 16 + j, b = combo >> 4, cblk = combo & 15;
            SkItem it{xb + (size_t)(b * SEQ + s2) * DI + cblk * 256, (size_t)64 * DI, ap + ((size_t)(b * 64) * 128 + s2) * DI + cblk * 256, nullptr, nullptr, nullptr};
            sk_core<1, 64>(C, L, it);
        }
    }
}
__device__ __forceinline__ void fft2_phase(const Ctx& C, const bf16_t* ap, const bf16_t* m2, bf16_t* cs) {
    LAS unsigned char* L = (LAS unsigned char*)C.lds;
    __syncthreads();
#pragma unroll
    for (int i = 0; i < 4; ++i) { const int idx = C.tid * 8 + i * 4096, r = idx >> 7, c = idx & 127;
        *(LAS u32x4*)(L + r * 272 + c * 2) = *(const u32x4*)(m2 + idx); }
#pragma unroll 1
    for (int item = C.bid; item < 4096; item += C.G) {
        const int cblk = item & 15, k1 = (item >> 4) & 63, b = item >> 10;
        SkItem it{ap + ((size_t)(b * 64 + k1) * 128) * DI + cblk * 256, (size_t)DI, cs + (size_t)(b * SEQ + k1) * 8192 + (cblk >> 1) * 1024 + (cblk & 1) * 256, nullptr, nullptr, nullptr};
        sk_core<2, 128>(C, L, it);
    }
}
template <int W>
__device__ __forceinline__ void pool_rows(const bf16_t* xc, const bf16_t* sg, bf16_t* p, int tok0, int ntok, int c8) {
    constexpr int LO = W / 2, TPI = 16 / W;
    for (int t0 = 0; t0 < ntok; t0 += TPI) {
        u32x4 q[TPI][W], gq[TPI];
#pragma unroll
        for (int tt = 0; tt < TPI; ++tt) {
            const int tok = tok0 + t0 + tt, spos = tok & (SEQ - 1), base = tok - spos;
            gq[tt] = *(const u32x4*)(sg + (size_t)tok * DI + c8);
#pragma unroll
            for (int j = 0; j < W; ++j) { int r = spos - LO + j; r = r < 0 ? 0 : (r > SEQ - 1 ? SEQ - 1 : r); q[tt][j] = *(const u32x4*)(xc + (size_t)(base + r) * DI + c8); }
        }
#pragma unroll
        for (int tt = 0; tt < TPI; ++tt) {
            const int tok = tok0 + t0 + tt, spos = tok & (SEQ - 1);
            float s[8] = {0.f, 0.f, 0.f, 0.f, 0.f, 0.f, 0.f, 0.f}; int cnt = 0;
#pragma unroll
            for (int j = 0; j < W; ++j) {
                const int r = spos - LO + j; const bool ok = (r >= 0) && (r <= SEQ - 1); const float f = ok ? 1.f : 0.f; cnt += ok ? 1 : 0;
                const u32x4 v = q[tt][j];
                s[0] += f * bf_lo(v.x); s[1] += f * bf_hi(v.x); s[2] += f * bf_lo(v.y); s[3] += f * bf_hi(v.y);
                s[4] += f * bf_lo(v.z); s[5] += f * bf_hi(v.z); s[6] += f * bf_lo(v.w); s[7] += f * bf_hi(v.w);
            }
            const float ic = 1.0f / (float)cnt; const u32x4 me = q[tt][LO]; const u32x4 g = gq[tt];
            u32x4 o;
            o.x = cvt_pk_bf16((s[0] * ic - bf_lo(me.x)) * bf_lo(g.x), (s[1] * ic - bf_hi(me.x)) * bf_hi(g.x)); o.y = cvt_pk_bf16((s[2] * ic - bf_lo(me.y)) * bf_lo(g.y), (s[3] * ic - bf_hi(me.y)) * bf_hi(g.y));
            o.z = cvt_pk_bf16((s[4] * ic - bf_lo(me.z)) * bf_lo(g.z), (s[5] * ic - bf_hi(me.z)) * bf_hi(g.z)); o.w = cvt_pk_bf16((s[6] * ic - bf_lo(me.w)) * bf_lo(g.w), (s[7] * ic - bf_hi(me.w)) * bf_hi(g.w));
            *(u32x4*)(p + (size_t)tok * DI + c8) = o;
        }
    }
}
__device__ __forceinline__ void pool_phase(const Ctx& C, const bf16_t* xc, const bf16_t* sg, bf16_t* p) {
    const int c8 = C.tid * 8; const int grp = C.wave >> 1;
    for (int blk = C.bid; blk < MTOK / 64; blk += C.G) {
        if (grp == 0) pool_rows<2>(xc, sg, p, blk * 64, 64, c8);
        else if (grp == 1) pool_rows<4>(xc, sg, p, blk * 64, 64, c8);
        else if (grp == 2) pool_rows<8>(xc, sg, p, blk * 64, 64, c8);
        else pool_rows<16>(xc, sg, p, blk * 64, 64, c8);
    }
}

__device__ __forceinline__ void grid_bar(unsigned* base, unsigned gen, unsigned G) {
    asm volatile("s_waitcnt vmcnt(0) lgkmcnt(0)" ::: "memory");
    __syncthreads();
    if (threadIdx.x == 0) {
        __builtin_amdgcn_fence(__ATOMIC_RELEASE, "agent");
        asm volatile("s_waitcnt vmcnt(0)" ::: "memory");
        unsigned* flag = base + 64 * (1 + (blockIdx.x >> 3));
        (void)__hip_atomic_fetch_add(base, 1u, __ATOMIC_RELAXED, __HIP_MEMORY_SCOPE_AGENT);
        if ((blockIdx.x & 7u) == 0u) {
            while (__hip_atomic_load(base, __ATOMIC_RELAXED, __HIP_MEMORY_SCOPE_AGENT) < gen * G) __builtin_amdgcn_s_sleep(1);
            __hip_atomic_store(flag, gen, __ATOMIC_RELAXED, __HIP_MEMORY_SCOPE_AGENT);
        } else {
            while (__hip_atomic_load(flag, __ATOMIC_RELAXED, __HIP_MEMORY_SCOPE_AGENT) < gen) __builtin_amdgcn_s_sleep(1);
        }
        __builtin_amdgcn_fence(__ATOMIC_ACQUIRE, "agent");
        asm volatile("s_waitcnt vmcnt(0)" ::: "memory");
    }
    __syncthreads();
}

struct Args { const float* in[17]; float* out; unsigned char* ws; int ph_lo, ph_hi; };

#define PHASE_BEGIN if (ph >= lo && ph < hi) { \
        unsigned char* ws = args.ws; asm volatile("" : "+s"(ws)); int tid_ = threadIdx.x; asm volatile("" : "+v"(tid_)); \
        Ctx C; C.tid = tid_; C.lane = tid_ & 63; C.wave = __builtin_amdgcn_readfirstlane(tid_ >> 6); C.G = gridDim.x; C.bid = blockIdx.x; C.lds = lds_raw; \
        LAS unsigned char* ldsl = (LAS unsigned char*)lds_raw; (void)ldsl; (void)ws;
#define PHASE_END   if (ph + 1 < hi) { if (ph == 0) grid.sync(); else { ++nbar; grid_bar((unsigned*)(args.ws + WS_BAR), nbar, gridDim.x); } } } ++ph;
#define WSP(T, off) ((T*)(ws + (off)))

#define GEMM_OUT(TBUF, XCUR) PHASE_BEGIN { \
        pg8::Sched S{64, 8, 64 * 8, C.G, C.bid, 1, WSP(bf16_t, TBUF), WSP(bf16_t, WS_WOUT), 0, 0, (size_t)256 * DI, 0, 0, (size_t)256 * DI}; \
        EpiOut E{XCUR, args.out}; \
        pg8::gemm_phase<EpiOut>(ldsl, C.tid, DI, DI, DI, S, E); } PHASE_END

#define LAYER_A(J, XCUR, FIRST) \
    PHASE_BEGIN REP(2) { int base = 0; \
        conv_mat(C, args.in[2] + (size_t)(J) * DM * 3 * DI, 3 * DI, DM, 3 * DI, WSP(bf16_t, WS_WIN), 1, base); \
        conv_mat(C, args.in[6] + (size_t)(J) * DI * DM, DM, DI, DM, WSP(bf16_t, WS_WOUT), 0, base); \
        if (FIRST) gen_tables(C, WSP(bf16_t, WS_CS), WSP(bf16_t, WS_M1), WSP(bf16_t, WS_M2)); \
        norm_phase(C, XCUR, args.in[1] + (size_t)(J) * DM, WSP(bf16_t, WS_RB)); } PHASE_END \
    PHASE_BEGIN REP(8) { \
        pg8::Sched S{64, 48, 64 * 48, C.G, C.bid, 1, WSP(bf16_t, WS_RB), WSP(bf16_t, WS_WIN), 0, 0, (size_t)256 * DM, 0, 0, (size_t)256 * DM}; \
        EpiA1 E{WSP(bf16_t, WS_RC), WSP(bf16_t, WS_RD), WSP(float, WS_SS)}; \
        pg8::gemm_phase<EpiA1>(ldsl, C.tid, DM, DM, DM, S, E); } PHASE_END \
    PHASE_BEGIN REP(1) { \
        mixA_phase(C, WSP(bf16_t, WS_RC), WSP(bf16_t, WS_RD), WSP(float, WS_SS), args.in[4] + (size_t)(J) * 8 * 128 * 128, args.in[5] + (size_t)(J) * 8 * 128, args.in[3] + (size_t)(J) * DI, WSP(bf16_t, WS_RE)); } PHASE_END \
    GEMM_OUT(WS_RE, XCUR)

#define LAYER_B(XCUR) \
    PHASE_BEGIN REP(2) { int base = 0; \
        conv_mat(C, args.in[8], 2 * DI, DM, 2 * DI, WSP(bf16_t, WS_WIN), 0, base); \
        conv_mat(C, args.in[10], DM, DI, DM, WSP(bf16_t, WS_WOUT), 0, base); \
        for (int g = 0; g < 8; ++g) conv_mat(C, args.in[9] + (size_t)g * 512 * 512, 512, 512, 512, WSP(bf16_t, WS_WMTB) + (size_t)g * 512 * 512, 0, base); \
        norm_phase(C, XCUR, args.in[7], WSP(bf16_t, WS_RB)); } PHASE_END \
    PHASE_BEGIN { \
        pg8::Sched S{2, 4, 8 * 2 * 4, C.G, C.bid, 1, WSP(bf16_t, WS_WMTB), WSP(bf16_t, WS_CS), (size_t)512 * 512, 0, (size_t)256 * 512, 0, 0, (size_t)256 * 512}; \
        EpiPre E{WSP(bf16_t, WS_WMIX)}; \
        pg8::gemm_phase<EpiPre>(ldsl, C.tid, 512, 512, 512, S, E); } \
        if (ph + 1 < hi) {   } } ++ph; \
    PHASE_BEGIN { \
        pg8::Sched S{64, 32, 64 * 32, C.G, C.bid, 1, WSP(bf16_t, WS_RB), WSP(bf16_t, WS_WIN), 0, 0, (size_t)256 * DM, 0, 0, (size_t)256 * DM}; \
        EpiBC1 E{WSP(bf16_t, WS_RC), WSP(bf16_t, WS_RA)}; \
        pg8::gemm_phase<EpiBC1>(ldsl, C.tid, DM, DM, DM, S, E); } PHASE_END \
    PHASE_BEGIN REP(4) { fft1_phase(C, WSP(bf16_t, WS_RC), WSP(bf16_t, WS_M1), WSP(bf16_t, WS_RD)); } PHASE_END \
    PHASE_BEGIN REP(4) { fft2_phase(C, WSP(bf16_t, WS_RD), WSP(bf16_t, WS_M2), WSP(bf16_t, WS_RB)); } PHASE_END \
    PHASE_BEGIN REP(32) { \
        pg8::Sched S{64, 2, 8 * 64 * 2, C.G, C.bid, 1, WSP(bf16_t, WS_RB), WSP(bf16_t, WS_WMIX), 1024, 0, (size_t)256 * 8192, (size_t)512 * 1024, 0, (size_t)256 * 1024}; \
        EpiGate E{WSP(bf16_t, WS_RD), WSP(bf16_t, WS_RA), nullptr, 6.9053396600248786e-4f, 0, 512}; \
        pg8::gemm_phase<EpiGate>(ldsl, C.tid, 1024, 8192, 1024, S, E); } PHASE_END \
    GEMM_OUT(WS_RD, XCUR)

#define LAYER_C(XCUR) \
    PHASE_BEGIN REP(2) { int base = 0; \
        conv_mat(C, args.in[12] + DI, 2 * DI, DM, DI, WSP(bf16_t, WS_WIN) + (size_t)DI * DM, 0, base); \
        copy_cvt(C, args.in[12], 2 * DI, DM, DI, WSP(bf16_t, WS_WIN) + (size_t)2 * DI * DM); \
        conv_mat(C, args.in[15], DM, DI, DM, WSP(bf16_t, WS_WOUT), 0, base); \
        for (int g = 0; g < 4; ++g) conv_mat(C, args.in[13] + (size_t)g * 1024 * 1024, 1024, 1024, 1024, WSP(bf16_t, WS_WMIX) + (size_t)g * 1024 * 1024, 0, base); \
        norm_phase(C, XCUR, args.in[11], WSP(bf16_t, WS_RB)); } PHASE_END \
    PHASE_BEGIN {   \
        pg8::Sched S{4, 8, 4 * 4 * 8, C.G, C.bid, 1, WSP(bf16_t, WS_WMIX), WSP(bf16_t, WS_WIN) + (size_t)2 * DI * DM, (size_t)1024 * 1024, 0, (size_t)256 * 1024, 1024, 0, (size_t)256 * DI}; \
        EpiW E{WSP(bf16_t, WS_WIN), args.in[14]}; \
        pg8::gemm_phase<EpiW>(ldsl, C.tid, 1024, 1024, DI, S, E); } PHASE_END \
    PHASE_BEGIN REP(16) { \
        pg8::Sched S{64, 32, 64 * 32, C.G, C.bid, 1, WSP(bf16_t, WS_RB), WSP(bf16_t, WS_WIN), 0, 0, (size_t)256 * DM, 0, 0, (size_t)256 * DM}; \
        EpiBC1 E{WSP(bf16_t, WS_RC), WSP(bf16_t, WS_RA)}; \
        pg8::gemm_phase<EpiBC1>(ldsl, C.tid, DM, DM, DM, S, E); } PHASE_END \
    PHASE_BEGIN REP(128) { pool_phase(C, WSP(bf16_t, WS_RC), WSP(bf16_t, WS_RA), WSP(bf16_t, WS_RE)); } PHASE_END \
    GEMM_OUT(WS_RE, XCUR)

__global__ void __launch_bounds__(NTHR, 2) fwd_mega(Args args) {
    extern __shared__ __attribute__((aligned(16))) unsigned char lds_raw[];
    cg::grid_group grid = cg::this_grid();
    int ph = 0; unsigned nbar = 0;
    const int lo = args.ph_lo, hi = args.ph_hi;
    if (blockIdx.x == 0 && threadIdx.x < 64) __hip_atomic_store((unsigned*)(args.ws + WS_BAR) + 64 * threadIdx.x, 0u, __ATOMIC_RELAXED, __HIP_MEMORY_SCOPE_AGENT);
    LAYER_A(0, args.in[0], true)
#if RUN_B
    LAYER_B(args.out)
#endif
#if RUN_C
    LAYER_C(args.out)
#endif
#if RUN_A2
    LAYER_A(1, args.out, false)
#endif
    PHASE_BEGIN { final_norm_phase(C, args.out, args.in[16]); } PHASE_END
}

extern "C" void kernel_launch(void* const* d_in, const int* in_sizes, int n_in, void* d_out, int out_size, void* d_ws, size_t ws_size, hipStream_t stream) {
    static int grid = 0;
    if (grid == 0) {
        if (n_in != 17 || ws_size < WS_END) { fprintf(stderr, "kernel_launch: unexpected n_in %d / ws_size %zu (need %zu)\n", n_in, ws_size, (size_t)WS_END); grid = -1; return; }
        int dev = 0, cus = 0, per_cu = 0;
        hipGetDevice(&dev); hipDeviceGetAttribute(&cus, hipDeviceAttributeMultiprocessorCount, dev);
        if (hipFuncSetAttribute((const void*)fwd_mega, hipFuncAttributeMaxDynamicSharedMemorySize, LDS_BYTES) != hipSuccess) { fprintf(stderr, "kernel_launch: hipFuncSetAttribute failed\n"); grid = -1; return; }
        if (hipOccupancyMaxActiveBlocksPerMultiprocessor(&per_cu, (const void*)fwd_mega, NTHR, LDS_BYTES) != hipSuccess || per_cu < 1) { fprintf(stderr, "kernel_launch: occupancy query says %d\n", per_cu); per_cu = 1; }
        (void)hipGetLastError();
        grid = cus;
        fprintf(stderr, "kernel_launch: grid %d (per_cu %d), ws %zu\n", grid, per_cu, ws_size);
    }
    if (grid < 0) return;
    Args a{};
    for (int i = 0; i < 17; ++i) a.in[i] = (const float*)d_in[i];
    a.out = (float*)d_out; a.ws = (unsigned char*)d_ws;
    hipError_t e = hipSuccess;
#if MULTI_LAUNCH
    for (int p = 0; p < 20 && e == hipSuccess; ++p) { a.ph_lo = p; a.ph_hi = p + 1; void* kargs[] = {&a};
        e = hipLaunchCooperativeKernel((const void*)fwd_mega, dim3(grid), dim3(NTHR), kargs, LDS_BYTES, stream); }
#else
    a.ph_lo = 0; a.ph_hi = 1000;
    void* kargs[] = {&a};
    e = hipLaunchCooperativeKernel((const void*)fwd_mega, dim3(grid), dim3(NTHR), kargs, LDS_BYTES, stream);
#endif
    if (e != hipSuccess) fprintf(stderr, "kernel_launch: cooperative launch failed: %s\n", hipGetErrorString(e));
}
```

```cpp
#include <hip/hip_runtime.h>
#include <hip/hip_cooperative_groups.h>
#include <cstdio>
#include <cstdint>
namespace cg = cooperative_groups;

#define LAS __attribute__((address_space(3)))
typedef unsigned short bf16_t;
typedef short bf16x8 __attribute__((ext_vector_type(8)));
typedef float f32x4 __attribute__((ext_vector_type(4)));
typedef unsigned u32x4 __attribute__((ext_vector_type(4)));
typedef unsigned u32x2 __attribute__((ext_vector_type(2)));

constexpr int MTOK = 16384, DM = 2048, DI = 4096, SEQ = 4096;
constexpr float EPS = 1e-6f;
constexpr size_t MiB = (size_t)1 << 20;
constexpr size_t WS_WIN = 0, WS_WOUT = 48 * MiB, WS_WMIX = 64 * MiB, WS_WMTB = 72 * MiB, WS_CS = 76 * MiB, WS_M1 = 77 * MiB, WS_M2 = 78 * MiB;
constexpr size_t WS_RA = 80 * MiB, WS_RB = 208 * MiB, WS_RC = 336 * MiB, WS_RD = 464 * MiB, WS_RE = 592 * MiB, WS_SS = 720 * MiB, WS_BAR = 724 * MiB, WS_END = 725 * MiB;
constexpr int NTHR = 512;
constexpr int LDS_BYTES = 131072;
#ifndef MULTI_LAUNCH
#define MULTI_LAUNCH 0
#endif
#define RUN_B 1
#define RUN_C 1
#define RUN_A2 1
#ifndef DUP_MASK
#define DUP_MASK 0
#endif
#define REP(bit) for (int rep_ = 0; rep_ < (((DUP_MASK) & (bit)) ? 2 : 1); ++rep_)

typedef float f32x2_t __attribute__((ext_vector_type(2)));
typedef __bf16 bf16x2_t __attribute__((ext_vector_type(2)));
__device__ __forceinline__ unsigned cvt_pk_bf16(float lo, float hi) { const f32x2_t v = {lo, hi}; const bf16x2_t r = __builtin_convertvector(v, bf16x2_t); return __builtin_bit_cast(unsigned, r); }
__device__ __forceinline__ float bf_lo(unsigned w) { return __uint_as_float(w << 16); }
__device__ __forceinline__ float bf_hi(unsigned w) { return __uint_as_float(w & 0xffff0000u); }
__device__ __forceinline__ float gelu_t(float x) {
    const float y = x * (1.0f + 0.044715f * x * x);
    const float e = __builtin_amdgcn_exp2f(-2.0f * 0.7978845608f * 1.4426950409f * y);
    return x * __builtin_amdgcn_rcpf(1.0f + e);
}
__device__ __forceinline__ float silu_f(float x) { const float e = __builtin_amdgcn_exp2f(-1.4426950409f * x); return x * __builtin_amdgcn_rcpf(1.0f + e); }
__device__ __forceinline__ f32x2_t ex2_pk(f32x2_t a) { f32x2_t r; r.x = __builtin_amdgcn_exp2f(a.x); r.y = __builtin_amdgcn_exp2f(a.y); return r; }
__device__ __forceinline__ f32x2_t rcp_pk(f32x2_t a) { f32x2_t r; r.x = __builtin_amdgcn_rcpf(a.x); r.y = __builtin_amdgcn_rcpf(a.y); return r; }
__device__ __forceinline__ f32x2_t gelu_pk(f32x2_t v) { const f32x2_t y = v * (v * v * 0.044715f + 1.0f); return v * rcp_pk(ex2_pk(y * (-2.0f * 0.7978845608f * 1.4426950409f)) + 1.0f); }
__device__ __forceinline__ f32x2_t silu_pk(f32x2_t g) { return g * rcp_pk(ex2_pk(g * (-1.4426950409f)) + 1.0f); }
__device__ __forceinline__ f32x2_t gelu_silu_pk(f32x2_t u, f32x2_t g) {
    const f32x2_t y = u * (u * u * 0.044715f + 1.0f);
    const f32x2_t ea = ex2_pk(y * (-2.0f * 0.7978845608f * 1.4426950409f)), eg = ex2_pk(g * (-1.4426950409f));
    return (u * g) * rcp_pk((ea + 1.0f) * (eg + 1.0f));
}

namespace pg8 {
constexpr int BM = 256, BK = 64, HALF = 128, HTB = HALF * BK * 2, STAGE_BYTES = 8 * HTB, NXCD = 8, WGM = 8;
__host__ __device__ __forceinline__ int lds_byte(int r, int c) { const int st = (r >> 4) * 2 + (c >> 5), rr = r & 15, cc = c & 31, ob = rr * 64 + cc * 2; return st * 1024 + (ob ^ (((ob >> 9) & 1) << 5)); }
__host__ __device__ __forceinline__ void stage_rc(int b, int& R, int& C) { const int st = b / 1024, sb = b % 1024, swz = sb ^ (((sb >> 9) & 1) << 5); R = (st >> 1) * 16 + swz / 64; C = (st & 1) * 32 + (swz % 64) / 2; }
__host__ __device__ __forceinline__ int perm32(int rho) { const int n = rho >> 4, i = rho & 15; return 8 * (i >> 2) + 4 * n + (i & 3); }

struct Unit { const char* a; const char* b; int p, pm, pn; };

struct Sched {
    int nM, nN, nwg, G, c, P2;
    const bf16_t* A; const bf16_t* B;
    size_t sA1, sA2, sAm, sB1, sB2, sBn;
    __device__ __forceinline__ bool next(int i, Unit& u) const {
        const long L = (long)i * G + c; if (L >= nwg) return false;
        int wgid = (int)L; { const int q = nwg / NXCD, r = nwg % NXCD, xcd = wgid % NXCD, off = wgid / NXCD; wgid = (xcd < r ? xcd * (q + 1) : r * (q + 1) + (xcd - r) * q) + off; }
        const int per = nM * nN; const int p = wgid / per, w = wgid % per;
        const int nig = WGM * nN, gid = w / nig, fm = gid * WGM, gsz = (nM - fm) < WGM ? (nM - fm) : WGM;
        u.p = p; u.pm = fm + ((w % nig) % gsz); u.pn = (w % nig) / gsz;
        const int p1 = p / P2, p2 = p % P2;
        u.a = (const char*)(A + (size_t)p1 * sA1 + (size_t)p2 * sA2 + (size_t)u.pm * sAm);
        u.b = (const char*)(B + (size_t)p1 * sB1 + (size_t)p2 * sB2 + (size_t)u.pn * sBn);
        return true;
    }
};

template <class Epi>
__device__ __forceinline__ void gemm_phase(LAS unsigned char* lds, const int tid, const int K, const int lda, const int ldb, const Sched& S, const Epi& E) {
    const int wid = __builtin_amdgcn_readfirstlane(tid >> 6), lane = tid & 63, wr = wid >> 2, wc = wid & 3, fr = lane & 15, fq = lane >> 4;
    const int nt = K / BK;
    unsigned voffA[2], voffB[2];
#pragma unroll
    for (int i = 0; i < 2; ++i) { int R, C; stage_rc(tid * 16 + i * 8192, R, C); const int Rb = Epi::PERM ? ((R & ~31) + perm32(R & 31)) : R;
        voffA[i] = (unsigned)(R * lda + C) * 2u; voffB[i] = (unsigned)(Rb * ldb + C) * 2u; }
    const size_t kstep = (size_t)(BK * 2);
    const size_t hstepA = (size_t)HALF * lda * 2, hstepB = (size_t)HALF * ldb * 2;
    const unsigned ldsw = (unsigned)wid * 1024u;
    const int aoff = lds_byte(wr * 64 + fr, fq * 8), boff = lds_byte(wc * 32 + fr, fq * 8);
#define PG8_SA(b, h) (((b) * 2 + (h)) * HTB)
#define PG8_SB(b, h) ((4 + (b) * 2 + (h)) * HTB)
#define PG8_STAGE(bufoff, gbase, voff) do { _Pragma("unroll") for (int _i = 0; _i < 2; ++_i) \
        __builtin_amdgcn_global_load_lds((const unsigned*)((const char*)(gbase) + (voff)[_i]), (LAS unsigned*)(lds + (bufoff) + ldsw + _i * 8192), 16, 0, 0); } while (0)
#define PG8_LDA(dst, b, h) do { _Pragma("unroll") for (int m = 0; m < 4; ++m) _Pragma("unroll") for (int k = 0; k < 2; ++k) dst[m][k] = *(const LAS bf16x8*)(lds + PG8_SA(b, h) + aoff + m * 2048 + k * 1024); } while (0)
#define PG8_LDB(dst, b, h) do { _Pragma("unroll") for (int n = 0; n < 2; ++n) _Pragma("unroll") for (int k = 0; k < 2; ++k) dst[n][k] = *(const LAS bf16x8*)(lds + PG8_SB(b, h) + boff + n * 2048 + k * 1024); } while (0)
#define PG8_MMA(ai, bj, At, Bt) do { __builtin_amdgcn_s_setprio(1); _Pragma("unroll") for (int m = 0; m < 4; ++m) _Pragma("unroll") for (int n = 0; n < 2; ++n) _Pragma("unroll") for (int k = 0; k < 2; ++k) \
        acc[ai][bj][m][n] = __builtin_amdgcn_mfma_f32_16x16x32_bf16(Bt[n][k], At[m][k], acc[ai][bj][m][n], 0, 0, 0); __builtin_amdgcn_s_setprio(0); } while (0)
#define PG8_WAIT_V(n) asm volatile("s_waitcnt vmcnt(" #n ")" ::: "memory")
#define PG8_WAIT_L(n) asm volatile("s_waitcnt lgkmcnt(" #n ")" ::: "memory")
#define PG8_BAR __builtin_amdgcn_s_barrier()
#define PG8_SCHED __builtin_amdgcn_sched_barrier(0)
    Unit cur, nxt; int ui = 0;
    if (!S.next(0, cur)) return;
    f32x4 acc[2][2][4][2];
#pragma unroll
    for (int a = 0; a < 2; ++a)
#pragma unroll
        for (int b = 0; b < 2; ++b)
#pragma unroll
            for (int m = 0; m < 4; ++m)
#pragma unroll
                for (int n = 0; n < 2; ++n) acc[a][b][m][n] = (f32x4){0.f, 0.f, 0.f, 0.f};
    bf16x8 At[4][2], B0[2][2], B1[2][2];
    const char* cA = cur.a; const char* cB = cur.b;
    PG8_STAGE(PG8_SB(0, 0), cB, voffB); PG8_STAGE(PG8_SB(0, 1), cB + hstepB, voffB); PG8_STAGE(PG8_SA(0, 0), cA, voffA); PG8_STAGE(PG8_SA(0, 1), cA + hstepA, voffA);
    if (wr == 1) PG8_BAR;
    PG8_WAIT_V(2); PG8_BAR;
    PG8_STAGE(PG8_SB(1, 0), cB + kstep, voffB); PG8_STAGE(PG8_SA(1, 0), cA + kstep, voffA); PG8_STAGE(PG8_SB(1, 1), cB + hstepB + kstep, voffB);
    PG8_WAIT_V(6); PG8_BAR;
    for (;;) {
        const bool has_next = S.next(ui + 1, nxt);
        const char* nA = has_next ? nxt.a : cA; const char* nB = has_next ? nxt.b : cB;
        for (int t = 0; t < nt; t += 2) {
            const bool last = (t == nt - 2);
            const char* a1 = cA + (size_t)(t + 1) * kstep;
            const char* a2 = last ? nA : cA + (size_t)(t + 2) * kstep; const char* b2 = last ? nB : cB + (size_t)(t + 2) * kstep;
            const char* a3 = a2 + kstep; const char* b3 = b2 + kstep;
            PG8_LDB(B0, 0, 0); PG8_LDB(B1, 0, 1); PG8_SCHED; PG8_LDA(At, 0, 0); PG8_STAGE(PG8_SA(1, 1), a1 + hstepA, voffA);
            PG8_WAIT_V(8); PG8_WAIT_L(0); PG8_BAR; PG8_MMA(0, 0, At, B0); PG8_MMA(0, 1, At, B1); PG8_BAR; PG8_SCHED;
            PG8_LDA(At, 0, 1); PG8_STAGE(PG8_SB(0, 0), b2, voffB); PG8_STAGE(PG8_SB(0, 1), b2 + hstepB, voffB); PG8_STAGE(PG8_SA(0, 0), a2, voffA);
            PG8_WAIT_V(8); PG8_WAIT_L(0); PG8_BAR; PG8_MMA(1, 0, At, B0); PG8_MMA(1, 1, At, B1); PG8_BAR; PG8_SCHED;
            PG8_LDB(B0, 1, 0); PG8_LDB(B1, 1, 1); PG8_SCHED; PG8_LDA(At, 1, 0); PG8_STAGE(PG8_SA(0, 1), a2 + hstepA, voffA);
            PG8_WAIT_V(8); PG8_WAIT_L(0); PG8_BAR; PG8_MMA(0, 0, At, B0); PG8_MMA(0, 1, At, B1); PG8_BAR; PG8_SCHED;
            PG8_LDA(At, 1, 1); PG8_STAGE(PG8_SB(1, 0), b3, voffB); PG8_STAGE(PG8_SB(1, 1), b3 + hstepB, voffB); PG8_STAGE(PG8_SA(1, 0), a3, voffA);
            PG8_WAIT_V(8); PG8_WAIT_L(0); PG8_BAR; PG8_MMA(1, 0, At, B0); PG8_MMA(1, 1, At, B1); PG8_BAR; PG8_SCHED;
        }
        if (wr == 0) PG8_BAR;
        E(acc, cur, wr, wc, fr, fq);
        if (!has_next) break;
#pragma unroll
        for (int a = 0; a < 2; ++a)
#pragma unroll
            for (int b = 0; b < 2; ++b)
#pragma unroll
                for (int m = 0; m < 4; ++m)
#pragma unroll
                    for (int n = 0; n < 2; ++n) acc[a][b][m][n] = (f32x4){0.f, 0.f, 0.f, 0.f};
        cur = nxt; cA = nA; cB = nB; ++ui;
        if (wr == 1) PG8_BAR;
    }
    PG8_WAIT_V(0);
    PG8_BAR;
#undef PG8_SA
#undef PG8_SB
#undef PG8_STAGE
#undef PG8_LDA
#undef PG8_LDB
#undef PG8_MMA
#undef PG8_WAIT_V
#undef PG8_WAIT_L
#undef PG8_BAR
#undef PG8_SCHED
}
}

typedef f32x4 AccT[2][2][4][2];

struct EpiA1 {
    static constexpr bool PERM = true;
    bf16_t* ug; bf16_t* gv; float* sumsq;
    __device__ __forceinline__ void operator()(const AccT& acc, const pg8::Unit& u, int wr, int wc, int fr, int fq) const {
        const int row0 = u.pm * 256 + wr * 64 + fr;
        if (u.pn < 32) {
            const int ch0 = u.pn * 128 + wc * 32 + 8 * fq;
#pragma unroll
            for (int ai = 0; ai < 2; ++ai)
#pragma unroll
                for (int m = 0; m < 4; ++m) {
                    const f32x4 U0 = acc[ai][0][m][0], U1 = acc[ai][0][m][1], G0 = acc[ai][1][m][0], G1 = acc[ai][1][m][1];
                    const f32x2_t r0 = gelu_silu_pk((f32x2_t){U0[0], U0[1]}, (f32x2_t){G0[0], G0[1]}), r1 = gelu_silu_pk((f32x2_t){U0[2], U0[3]}, (f32x2_t){G0[2], G0[3]});
                    const f32x2_t r2 = gelu_silu_pk((f32x2_t){U1[0], U1[1]}, (f32x2_t){G1[0], G1[1]}), r3 = gelu_silu_pk((f32x2_t){U1[2], U1[3]}, (f32x2_t){G1[2], G1[3]});
                    u32x4 w; w.x = cvt_pk_bf16(r0.x, r0.y); w.y = cvt_pk_bf16(r1.x, r1.y); w.z = cvt_pk_bf16(r2.x, r2.y); w.w = cvt_pk_bf16(r3.x, r3.y);
                    *(u32x4*)(ug + (size_t)(row0 + ai * 128 + m * 16) * DI + ch0) = w;
                }
        } else {
            const int chb = (u.pn - 32) * 256 + wc * 32 + 8 * fq;
#pragma unroll
            for (int ai = 0; ai < 2; ++ai)
#pragma unroll
                for (int m = 0; m < 4; ++m) {
                    const int row = row0 + ai * 128 + m * 16; float ss = 0.f;
#pragma unroll
                    for (int bj = 0; bj < 2; ++bj) {
                        const f32x4 a0 = acc[ai][bj][m][0], a1 = acc[ai][bj][m][1];
                        const f32x2_t r0 = gelu_pk((f32x2_t){a0[0], a0[1]}), r1 = gelu_pk((f32x2_t){a0[2], a0[3]}), r2 = gelu_pk((f32x2_t){a1[0], a1[1]}), r3 = gelu_pk((f32x2_t){a1[2], a1[3]});
                        const f32x2_t q = (r0 * r0 + r1 * r1) + (r2 * r2 + r3 * r3); ss += q.x + q.y;
                        u32x4 w; w.x = cvt_pk_bf16(r0.x, r0.y); w.y = cvt_pk_bf16(r1.x, r1.y); w.z = cvt_pk_bf16(r2.x, r2.y); w.w = cvt_pk_bf16(r3.x, r3.y);
                        *(u32x4*)(gv + (size_t)row * DI + chb + bj * 128) = w;
                    }
                    ss += __shfl_xor(ss, 16); ss += __shfl_xor(ss, 32);
                    if (fq == 0) sumsq[(size_t)((u.pn - 32) * 4 + wc) * MTOK + row] = ss;
                }
        }
    }
};
struct EpiBC1 {
    static constexpr bool PERM = true;
    bf16_t* br; bf16_t* sg;
    __device__ __forceinline__ void operator()(const AccT& acc, const pg8::Unit& u, int wr, int wc, int fr, int fq) const {
        const int row0 = u.pm * 256 + wr * 64 + fr;
        const bool gate = u.pn >= 16;
        bf16_t* dst = gate ? sg : br;
        const int col0 = (gate ? u.pn - 16 : u.pn) * 256 + wc * 32 + 8 * fq;
#pragma unroll
        for (int ai = 0; ai < 2; ++ai)
#pragma unroll
            for (int m = 0; m < 4; ++m)
#pragma unroll
                for (int bj = 0; bj < 2; ++bj) {
                    f32x4 v0 = acc[ai][bj][m][0], v1 = acc[ai][bj][m][1];
                    if (gate) {
                        const f32x2_t r0 = silu_pk((f32x2_t){v0[0], v0[1]}), r1 = silu_pk((f32x2_t){v0[2], v0[3]}), r2 = silu_pk((f32x2_t){v1[0], v1[1]}), r3 = silu_pk((f32x2_t){v1[2], v1[3]});
                        v0 = (f32x4){r0.x, r0.y, r1.x, r1.y}; v1 = (f32x4){r2.x, r2.y, r3.x, r3.y};
                    }
                    u32x4 w; w.x = cvt_pk_bf16(v0[0], v0[1]); w.y = cvt_pk_bf16(v0[2], v0[3]); w.z = cvt_pk_bf16(v1[0], v1[1]); w.w = cvt_pk_bf16(v1[2], v1[3]);
                    *(u32x4*)(dst + (size_t)(row0 + ai * 128 + m * 16) * DI + col0 + bj * 128) = w;
                }
    }
};
struct EpiPre {
    static constexpr bool PERM = true;
    bf16_t* bt2;
    __device__ __forceinline__ void operator()(const AccT& acc, const pg8::Unit& u, int wr, int wc, int fr, int fq) const {
        const int g = u.p;
        const int d0 = u.pm * 256 + wr * 64 + fr, c0 = u.pn * 256 + wc * 32 + 8 * fq;
#pragma unroll
        for (int ai = 0; ai < 2; ++ai)
#pragma unroll
            for (int m = 0; m < 4; ++m)
#pragma unroll
                for (int bj = 0; bj < 2; ++bj) {
                    const f32x4 v0 = acc[ai][bj][m][0], v1 = acc[ai][bj][m][1];
                    u32x4 w; w.x = cvt_pk_bf16(v0[0], v0[1]); w.y = cvt_pk_bf16(v0[2], v0[3]); w.z = cvt_pk_bf16(v1[0], v1[1]); w.w = cvt_pk_bf16(v1[2], v1[3]);
                    *(u32x4*)(bt2 + ((size_t)(g * 512 + d0 + ai * 128 + m * 16)) * 1024 + c0 + bj * 128) = w;
                }
    }
};
struct EpiW {
    static constexpr bool PERM = true;
    bf16_t* w; const float* cscale;
    __device__ __forceinline__ void operator()(const AccT& acc, const pg8::Unit& u, int wr, int wc, int fr, int fq) const {
        const int row0 = u.p * 1024 + u.pm * 256 + wr * 64 + fr, col0 = u.pn * 256 + wc * 32 + 8 * fq;
#pragma unroll
        for (int ai = 0; ai < 2; ++ai)
#pragma unroll
            for (int m = 0; m < 4; ++m) {
                const int row = row0 + ai * 128 + m * 16; const float sc = cscale[row];
#pragma unroll
                for (int bj = 0; bj < 2; ++bj) {
                    const f32x4 v0 = acc[ai][bj][m][0] * sc, v1 = acc[ai][bj][m][1] * sc;
                    u32x4 q; q.x = cvt_pk_bf16(v0[0], v0[1]); q.y = cvt_pk_bf16(v0[2], v0[3]); q.z = cvt_pk_bf16(v1[0], v1[1]); q.w = cvt_pk_bf16(v1[2], v1[3]);
                    *(u32x4*)(w + (size_t)row * DM + col0 + bj * 128) = q;
                }
            }
    }
};
struct EpiGate {
    static constexpr bool PERM = true;
    bf16_t* t; const bf16_t* sg; const float* cscale; float sc; int rowsPerP, colsPerP;
    __device__ __forceinline__ void operator()(const AccT& acc, const pg8::Unit& u, int wr, int wc, int fr, int fq) const {
        const int row0 = u.p * rowsPerP + u.pm * 256 + wr * 64 + fr, col0 = u.p * colsPerP + u.pn * 256 + wc * 32 + 8 * fq;
        u32x4 gq[2][4][2];
#pragma unroll
        for (int ai = 0; ai < 2; ++ai)
#pragma unroll
            for (int m = 0; m < 4; ++m)
#pragma unroll
                for (int bj = 0; bj < 2; ++bj) gq[ai][m][bj] = *(const u32x4*)(sg + (size_t)(row0 + ai * 128 + m * 16) * DI + col0 + bj * 128);
        f32x4 s0[2], s1[2];
#pragma unroll
        for (int bj = 0; bj < 2; ++bj) {
            if (cscale) { s0[bj] = *(const f32x4*)(cscale + col0 + bj * 128); s1[bj] = *(const f32x4*)(cscale + col0 + bj * 128 + 4); }
            else { s0[bj] = (f32x4){sc, sc, sc, sc}; s1[bj] = s0[bj]; }
        }
#pragma unroll
        for (int ai = 0; ai < 2; ++ai)
#pragma unroll
            for (int m = 0; m < 4; ++m)
#pragma unroll
                for (int bj = 0; bj < 2; ++bj) {
                    const size_t off = (size_t)(row0 + ai * 128 + m * 16) * DI + col0 + bj * 128;
                    const u32x4 g = gq[ai][m][bj];
                    const f32x4 v0 = acc[ai][bj][m][0] * s0[bj], v1 = acc[ai][bj][m][1] * s1[bj];
                    u32x4 w;
                    w.x = cvt_pk_bf16(v0[0] * bf_lo(g.x), v0[1] * bf_hi(g.x)); w.y = cvt_pk_bf16(v0[2] * bf_lo(g.y), v0[3] * bf_hi(g.y));
                    w.z = cvt_pk_bf16(v1[0] * bf_lo(g.z), v1[1] * bf_hi(g.z)); w.w = cvt_pk_bf16(v1[2] * bf_lo(g.w), v1[3] * bf_hi(g.w));
                    *(u32x4*)(t + off) = w;
                }
    }
};
struct EpiOut {
    static constexpr bool PERM = false;
    const float* xold; float* xnew;
    __device__ __forceinline__ void operator()(const AccT& acc, const pg8::Unit& u, int wr, int wc, int fr, int fq) const {
        const int row0 = u.pm * 256 + wr * 64 + fr, col0 = u.pn * 256 + wc * 32 + 4 * fq;
#pragma unroll
        for (int ai = 0; ai < 2; ++ai) {
            f32x4 o[4][2][2];
#pragma unroll
            for (int m = 0; m < 4; ++m)
#pragma unroll
                for (int bj = 0; bj < 2; ++bj)
#pragma unroll
                    for (int n = 0; n < 2; ++n) o[m][bj][n] = *(const f32x4*)(xold + (size_t)(row0 + ai * 128 + m * 16) * DM + col0 + bj * 128 + n * 16);
            asm volatile("" ::: "memory");
#pragma unroll
            for (int m = 0; m < 4; ++m)
#pragma unroll
                for (int bj = 0; bj < 2; ++bj)
#pragma unroll
                    for (int n = 0; n < 2; ++n) *(f32x4*)(xnew + (size_t)(row0 + ai * 128 + m * 16) * DM + col0 + bj * 128 + n * 16) = o[m][bj][n] + acc[ai][bj][m][n];
            asm volatile("" ::: "memory");
        }
    }
};

struct Ctx { int tid, lane, wave, G, bid; unsigned char* lds; };

__device__ __forceinline__ void conv_tile(const Ctx& C, const float* src, int ldsrc, int k0, int c0, bf16_t* dst, int ldd, int n0) {
    float* T = (float*)C.lds;
    const int kk = C.tid >> 4, c4 = (C.tid & 15) * 4;
#pragma unroll
    for (int i = 0; i < 2; ++i) {
        const int k = kk + 32 * i;
        const f32x4 v = *(const f32x4*)(src + (size_t)(k0 + k) * ldsrc + c0 + c4);
        T[k * 65 + c4 + 0] = v[0]; T[k * 65 + c4 + 1] = v[1]; T[k * 65 + c4 + 2] = v[2]; T[k * 65 + c4 + 3] = v[3];
    }
    __syncthreads();
    const int n = C.tid >> 3, k8 = (C.tid & 7) * 8;
    u32x4 w;
    w.x = cvt_pk_bf16(T[(k8 + 0) * 65 + n], T[(k8 + 1) * 65 + n]); w.y = cvt_pk_bf16(T[(k8 + 2) * 65 + n], T[(k8 + 3) * 65 + n]);
    w.z = cvt_pk_bf16(T[(k8 + 4) * 65 + n], T[(k8 + 5) * 65 + n]); w.w = cvt_pk_bf16(T[(k8 + 6) * 65 + n], T[(k8 + 7) * 65 + n]);
    *(u32x4*)(dst + (size_t)(n0 + n) * ldd + k0 + k8) = w;
    __syncthreads();
}
__device__ __forceinline__ void copy_cvt(const Ctx& C, const float* src, int ldsrc, int rows, int ncols, bf16_t* dst) {
    const int per = ncols / 8, total = rows * per;
    for (int i = C.bid * NTHR + C.tid; i < total; i += C.G * NTHR) {
        const int r = i / per, c = (i % per) * 8;
        const f32x4 a = *(const f32x4*)(src + (size_t)r * ldsrc + c), b = *(const f32x4*)(src + (size_t)r * ldsrc + c + 4);
        u32x4 w; w.x = cvt_pk_bf16(a[0], a[1]); w.y = cvt_pk_bf16(a[2], a[3]); w.z = cvt_pk_bf16(b[0], b[1]); w.w = cvt_pk_bf16(b[2], b[3]);
        *(u32x4*)(dst + (size_t)r * ncols + c) = w;
    }
}
__device__ __forceinline__ void conv_mat(const Ctx& C, const float* src, int ldsrc, int K, int Nd, bf16_t* dst, int mode, int& base) {
    const int tk = K / 64, tn = Nd / 64, ntile = tk * tn;
    int start = (C.bid - (base % C.G) + C.G) % C.G;
    for (int t = start; t < ntile; t += C.G) {
        const int in_ = t / tk, ik = t % tk;
        const int n0 = in_ * 64;
        int c0 = n0;
        if (mode == 1) {
            if (n0 < 8192) { const int tile = n0 >> 8, r = n0 & 255; c0 = (r < 128) ? tile * 128 + r : 8192 + tile * 128 + (r - 128); }
            else c0 = 4096 + (n0 - 8192);
        }
        conv_tile(C, src, ldsrc, ik * 64, c0, dst, K, n0);
    }
    base += ntile;
}
__device__ __forceinline__ void norm_phase(const Ctx& C, const float* x, const float* gain, bf16_t* h) {
    for (int row = C.bid * 8 + C.wave; row < MTOK; row += C.G * 8) {
        const float* xr = x + (size_t)row * DM;
        f32x4 v[8]; float ss = 0.f;
#pragma unroll
        for (int j = 0; j < 4; ++j) {
            v[2 * j] = *(const f32x4*)(xr + (j * 64 + C.lane) * 8); v[2 * j + 1] = *(const f32x4*)(xr + (j * 64 + C.lane) * 8 + 4);
#pragma unroll
            for (int e = 0; e < 4; ++e) ss += v[2 * j][e] * v[2 * j][e] + v[2 * j + 1][e] * v[2 * j + 1][e];
        }
#pragma unroll
        for (int o = 1; o < 64; o <<= 1) ss += __shfl_xor(ss, o);
        const float rs = __builtin_amdgcn_rsqf(ss * (1.0f / DM) + EPS);
#pragma unroll
        for (int j = 0; j < 4; ++j) {
            const int c = (j * 64 + C.lane) * 8;
            const f32x4 g0 = *(const f32x4*)(gain + c), g1 = *(const f32x4*)(gain + c + 4);
            const f32x4 a = v[2 * j] * rs * g0, b = v[2 * j + 1] * rs * g1;
            u32x4 w; w.x = cvt_pk_bf16(a[0], a[1]); w.y = cvt_pk_bf16(a[2], a[3]); w.z = cvt_pk_bf16(b[0], b[1]); w.w = cvt_pk_bf16(b[2], b[3]);
            *(u32x4*)(h + (size_t)row * DM + c) = w;
        }
    }
}
__device__ __forceinline__ void final_norm_phase(const Ctx& C, float* x, const float* gain) {
    for (int row = C.bid * 8 + C.wave; row < MTOK; row += C.G * 8) {
        float* xr = x + (size_t)row * DM;
        f32x4 v[8]; float ss = 0.f;
#pragma unroll
        for (int j = 0; j < 8; ++j) {
            v[j] = *(const f32x4*)(xr + (j * 64 + C.lane) * 4);
#pragma unroll
            for (int e = 0; e < 4; ++e) ss += v[j][e] * v[j][e];
        }
#pragma unroll
        for (int o = 1; o < 64; o <<= 1) ss += __shfl_xor(ss, o);
        const float rs = __builtin_amdgcn_rsqf(ss * (1.0f / DM) + EPS);
#pragma unroll
        for (int j = 0; j < 8; ++j) {
            const int c = (j * 64 + C.lane) * 4;
            const f32x4 g0 = *(const f32x4*)(gain + c);
            *(f32x4*)(xr + c) = v[j] * rs * g0;
        }
    }
}
__device__ __forceinline__ void gen_tables(const Ctx& C, bf16_t* cs, bf16_t* m1, bf16_t* m2) {
    const int gt = C.bid * NTHR + C.tid, GT = C.G * NTHR;
    for (int i = gt; i < 1024 * 512 / 8; i += GT) {
        const int n = i / 64, d0 = (i % 64) * 8; const int c = n & 511; const bool sn = n >= 512;
        float v[8];
#pragma unroll
        for (int e = 0; e < 8; ++e) { const float rev = (float)((c * (d0 + e)) & 511) * (1.0f / 512.0f); v[e] = sn ? __builtin_amdgcn_sinf(rev) : __builtin_amdgcn_cosf(rev); }
        u32x4 w; w.x = cvt_pk_bf16(v[0], v[1]); w.y = cvt_pk_bf16(v[2], v[3]); w.z = cvt_pk_bf16(v[4], v[5]); w.w = cvt_pk_bf16(v[6], v[7]);
        *(u32x4*)(cs + (size_t)i * 8) = w;
    }
    for (int i = gt; i < 64 * 128 * 64 / 8; i += GT) {
        const int s2 = i >> 10, r = (i >> 3) & 127, s10 = (i & 7) * 8; const int k1 = r & 63; const bool sn = r >= 64;
        float v[8];
#pragma unroll
        for (int e = 0; e < 8; ++e) { const float rev = (float)(((64 * (s10 + e) + s2) * k1) & 4095) * (1.0f / 4096.0f); v[e] = sn ? __builtin_amdgcn_sinf(rev) : __builtin_amdgcn_cosf(rev); }
        u32x4 w; w.x = cvt_pk_bf16(v[0], v[1]); w.y = cvt_pk_bf16(v[2], v[3]); w.z = cvt_pk_bf16(v[4], v[5]); w.w = cvt_pk_bf16(v[6], v[7]);
        *(u32x4*)(m1 + (size_t)i * 8) = w;
    }
    for (int i = gt; i < 128 * 128 / 8; i += GT) {
        const int r = i >> 4, c0 = (i & 15) * 8; const int k2 = r & 63; const bool rim = r >= 64;
        float v[8];
#pragma unroll
        for (int e = 0; e < 8; ++e) { const int c = c0 + e, s2 = c & 63; const bool cim = c >= 64; const float rev = (float)((s2 * k2) & 63) * (1.0f / 64.0f);
            const float cs_ = __builtin_amdgcn_cosf(rev), sn_ = __builtin_amdgcn_sinf(rev);
            v[e] = rim ? (cim ? -cs_ : -sn_) : (cim ? -sn_ : cs_); }
        u32x4 w; w.x = cvt_pk_bf16(v[0], v[1]); w.y = cvt_pk_bf16(v[2], v[3]); w.z = cvt_pk_bf16(v[4], v[5]); w.w = cvt_pk_bf16(v[6], v[7]);
        *(u32x4*)(m2 + (size_t)i * 8) = w;
    }
}
typedef short s16x4 __attribute__((ext_vector_type(4)));
constexpr int SK_PITCH = 144, SK_AUX_OFF = 34816, SK_SLAB_OFF = 37376, SK_SLAB_BYTES = 128 * SK_PITCH;
struct SkItem { const bf16_t* in; size_t in_stride; bf16_t* out; const bf16_t* mul; const float* vg; const float* bs; };
template <int MODE> __device__ __forceinline__ size_t sk_out_off(int r) {
    if (MODE == 0) return (size_t)r * DI;
    if (MODE == 1) return (size_t)((r & 63) * 128 + (r >> 6) * 64) * DI;
    return (size_t)(r & 63) * 64 * 8192 + (size_t)(r >> 6) * 512;
}
template <int MODE, int KQ>
__device__ __forceinline__ void sk_core(const Ctx& C, LAS unsigned char* L, const SkItem& it) {
    constexpr int MP = (KQ + 8) * 2;
    const int pair = C.wave >> 1, hw = C.wave & 1, lp = hw * 64 + C.lane;
    const int fr = C.lane & 15, fq = C.lane >> 4, trq = (C.lane & 15) >> 2, trp = C.lane & 3;
    LAS unsigned char* slab = L + SK_SLAB_OFF + pair * SK_SLAB_BYTES;
    __syncthreads();
    {
        u32x4 v[KQ / 16];
#pragma unroll
        for (int i = 0; i < KQ / 16; ++i) v[i] = *(const u32x4*)(it.in + (size_t)((lp >> 3) + 16 * i) * it.in_stride + pair * 64 + (lp & 7) * 8);
#pragma unroll
        for (int i = 0; i < KQ / 16; ++i) *(LAS u32x4*)(slab + ((lp >> 3) + 16 * i) * SK_PITCH + (lp & 7) * 16) = v[i];
    }
    __syncthreads();
    f32x4 acc[4][4];
#pragma unroll
    for (int cb = 0; cb < 4; ++cb)
#pragma unroll
        for (int pb = 0; pb < 4; ++pb) acc[cb][pb] = (f32x4){0.f, 0.f, 0.f, 0.f};
#pragma unroll
    for (int kb = 0; kb < KQ / 32; ++kb) {
        bf16x8 af[4];
#pragma unroll
        for (int cb = 0; cb < 4; ++cb) {
            const s16x4 t0 = __builtin_amdgcn_ds_read_tr16_b64_v4i16((LAS s16x4*)(slab + (32 * kb + 8 * fq + trq) * SK_PITCH + (16 * cb + 4 * trp) * 2));
            const s16x4 t1 = __builtin_amdgcn_ds_read_tr16_b64_v4i16((LAS s16x4*)(slab + (32 * kb + 8 * fq + 4 + trq) * SK_PITCH + (16 * cb + 4 * trp) * 2));
            af[cb] = (bf16x8){t0[0], t0[1], t0[2], t0[3], t1[0], t1[1], t1[2], t1[3]};
        }
#pragma unroll
        for (int pb = 0; pb < 4; ++pb) {
            const bf16x8 bfr = *(const LAS bf16x8*)(L + (64 * hw + pb * 16 + fr) * MP + (kb * 32 + fq * 8) * 2);
#pragma unroll
            for (int cb = 0; cb < 4; ++cb) acc[cb][pb] = __builtin_amdgcn_mfma_f32_16x16x32_bf16(af[cb], bfr, acc[cb][pb], 0, 0, 0);
        }
    }
    __syncthreads();
#pragma unroll
    for (int cb = 0; cb < 4; ++cb) {
        f32x4 vg = (f32x4){1.f, 1.f, 1.f, 1.f};
        if (MODE == 0) vg = *(const f32x4*)(it.vg + pair * 64 + cb * 16 + 4 * fq);
#pragma unroll
        for (int pb = 0; pb < 4; ++pb) {
            const int row = 64 * hw + pb * 16 + fr;
            f32x4 v = acc[cb][pb];
            if (MODE == 0) v = v * vg + it.bs[row];
            u32x2 w; w.x = cvt_pk_bf16(v[0], v[1]); w.y = cvt_pk_bf16(v[2], v[3]);
            *(LAS u32x2*)(slab + row * SK_PITCH + (cb * 16 + 4 * fq) * 2) = w;
        }
    }
    u32x4 mv[8];
    if (MODE == 0) {
#pragma unroll
        for (int i = 0; i < 8; ++i) mv[i] = *(const u32x4*)(it.mul + (size_t)(64 * hw + i * 8 + (C.lane >> 3)) * DI + pair * 64 + (C.lane & 7) * 8);
    }
#pragma unroll
    for (int i = 0; i < 8; ++i) {
        const int row = 64 * hw + i * 8 + (C.lane >> 3);
        u32x4 sv = *(const LAS u32x4*)(slab + row * SK_PITCH + (C.lane & 7) * 16);
        if (MODE == 0) {
            const u32x4 m = mv[i];
            sv.x = cvt_pk_bf16(bf_lo(sv.x) * bf_lo(m.x), bf_hi(sv.x) * bf_hi(m.x)); sv.y = cvt_pk_bf16(bf_lo(sv.y) * bf_lo(m.y), bf_hi(sv.y) * bf_hi(m.y));
            sv.z = cvt_pk_bf16(bf_lo(sv.z) * bf_lo(m.z), bf_hi(sv.z) * bf_hi(m.z)); sv.w = cvt_pk_bf16(bf_lo(sv.w) * bf_lo(m.w), bf_hi(sv.w) * bf_hi(m.w));
        }
        *(u32x4*)(it.out + sk_out_off<MODE>(row) + pair * 64 + (C.lane & 7) * 8) = sv;
    }
}
__device__ __forceinline__ void mixA_phase(const Ctx& C, const bf16_t* ug, const bf16_t* gv, const float* sumsq, const float* w_s, const float* b_s, const float* v_gain, bf16_t* t) {
    constexpr int WP = 136;
    LAS unsigned char* L = (LAS unsigned char*)C.lds;
    float* rstd = (float*)(C.lds + SK_AUX_OFF);
    float* red = (float*)(C.lds + SK_AUX_OFF + 512);
    bf16_t* Wl = (bf16_t*)C.lds;
    for (int item = C.bid; item < 1024; item += C.G) {
        const int g = item & 7, n = item >> 3;
        __syncthreads();
        {
            const int r = C.tid & 127, part = C.tid >> 7; float a = 0.f;
#pragma unroll
            for (int i = 0; i < 16; ++i) a += sumsq[(size_t)(part * 16 + i) * MTOK + n * 128 + r];
            red[part * 128 + r] = a;
            __syncthreads();
            if (C.tid < 128) rstd[C.tid] = __builtin_amdgcn_rsqf(((red[C.tid] + red[128 + C.tid]) + (red[256 + C.tid] + red[384 + C.tid])) * (1.0f / DI) + EPS);
        }
        __syncthreads();
        {
            const int p = C.tid >> 2, q0 = (C.tid & 3) * 32;
            const float* wsrc = w_s + ((size_t)g * 128 + p) * 128 + q0;
#pragma unroll
            for (int j = 0; j < 4; ++j) {
                const f32x4 a = *(const f32x4*)(wsrc + j * 8), b = *(const f32x4*)(wsrc + j * 8 + 4);
                const int q = q0 + j * 8;
                u32x4 w;
                w.x = cvt_pk_bf16(a[0] * rstd[q + 0], a[1] * rstd[q + 1]); w.y = cvt_pk_bf16(a[2] * rstd[q + 2], a[3] * rstd[q + 3]);
                w.z = cvt_pk_bf16(b[0] * rstd[q + 4], b[1] * rstd[q + 5]); w.w = cvt_pk_bf16(b[2] * rstd[q + 6], b[3] * rstd[q + 7]);
                *(u32x4*)(Wl + p * WP + q) = w;
            }
        }
        const size_t off0 = (size_t)n * 128 * DI + g * 512;
#pragma unroll 1
        for (int h = 0; h < 2; ++h) {
            SkItem it{gv + off0 + h * 256, (size_t)DI, t + off0 + h * 256, ug + off0 + h * 256, v_gain + g * 512 + h * 256, b_s + g * 128};
            sk_core<0, 128>(C, L, it);
        }
    }
}
__device__ __forceinline__ void fft1_phase(const Ctx& C, const bf16_t* xb, const bf16_t* m1, bf16_t* ap) {
    LAS unsigned char* L = (LAS unsigned char*)C.lds;
    for (int w = C.bid; w < 256; w += C.G) {
        const int s2 = w >> 2, sub = w & 3;
        __syncthreads();
#pragma unroll
        for (int i = 0; i < 2; ++i) { const int idx = C.tid * 8 + i * 4096, r = idx >> 6, c = idx & 63;
            *(LAS u32x4*)(L + r * 144 + c * 2) = *(const u32x4*)(m1 + (size_t)s2 * 8192 + idx); }
#pragma unroll 1
        for (int j = 0; j < 16; ++j) {
            const int combo = sub * 16 + j, b = combo >> 4, cblk = combo & 15;
            SkItem it{xb + (size_t)(b * SEQ + s2) * DI + cblk * 256, (size_t)64 * DI, ap + ((size_t)(b * 64) * 128 + s2) * DI + cblk * 256, nullptr, nullptr, nullptr};
            sk_core<1, 64>(C, L, it);
        }
    }
}
__device__ __forceinline__ void fft2_phase(const Ctx& C, const bf16_t* ap, const bf16_t* m2, bf16_t* cs) {
    LAS unsigned char* L = (LAS unsigned char*)C.lds;
    __syncthreads();
#pragma unroll
    for (int i = 0; i < 4; ++i) { const int idx = C.tid * 8 + i * 4096, r = idx >> 7, c = idx & 127;
        *(LAS u32x4*)(L + r * 272 + c * 2) = *(const u32x4*)(m2 + idx); }
#pragma unroll 1
    for (int item = C.bid; item < 4096; item += C.G) {
        const int cblk = item & 15, k1 = (item >> 4) & 63, b = item >> 10;
        SkItem it{ap + ((size_t)(b * 64 + k1) * 128) * DI + cblk * 256, (size_t)DI, cs + (size_t)(b * SEQ + k1) * 8192 + (cblk >> 1) * 1024 + (cblk & 1) * 256, nullptr, nullptr, nullptr};
        sk_core<2, 128>(C, L, it);
    }
}
template <int W, int TOK>
__device__ __forceinline__ void pool_rows(const bf16_t* xc, const bf16_t* sg, bf16_t* p, int tok0, int ntok, int c8) {
    constexpr int LO = W / 2, NR = W + TOK - 1;
    for (int t0 = 0; t0 < ntok; t0 += TOK) {
        const int tokb = tok0 + t0, spos0 = tokb & (SEQ - 1), base = tokb - spos0;
        u32x4 q[NR], gq[TOK];
#pragma unroll
        for (int j = 0; j < NR; ++j) { int r = spos0 - LO + j; r = r < 0 ? 0 : (r > SEQ - 1 ? SEQ - 1 : r); q[j] = *(const u32x4*)(xc + (size_t)(base + r) * DI + c8); }
#pragma unroll
        for (int tt = 0; tt < TOK; ++tt) gq[tt] = *(const u32x4*)(sg + (size_t)(tokb + tt) * DI + c8);
#pragma unroll
        for (int tt = 0; tt < TOK; ++tt) {
            float s[8] = {0.f, 0.f, 0.f, 0.f, 0.f, 0.f, 0.f, 0.f}; int cnt = 0;
#pragma unroll
            for (int j = 0; j < W; ++j) {
                const int r = spos0 + tt - LO + j; const bool ok = (r >= 0) && (r <= SEQ - 1); const float f = ok ? 1.f : 0.f; cnt += ok ? 1 : 0;
                const u32x4 v = q[tt + j];
                s[0] += f * bf_lo(v.x); s[1] += f * bf_hi(v.x); s[2] += f * bf_lo(v.y); s[3] += f * bf_hi(v.y);
                s[4] += f * bf_lo(v.z); s[5] += f * bf_hi(v.z); s[6] += f * bf_lo(v.w); s[7] += f * bf_hi(v.w);
            }
            const float ic = 1.0f / (float)cnt; const u32x4 me = q[tt + LO]; const u32x4 g = gq[tt];
            u32x4 o;
            o.x = cvt_pk_bf16((s[0] * ic - bf_lo(me.x)) * bf_lo(g.x), (s[1] * ic - bf_hi(me.x)) * bf_hi(g.x)); o.y = cvt_pk_bf16((s[2] * ic - bf_lo(me.y)) * bf_lo(g.y), (s[3] * ic - bf_hi(me.y)) * bf_hi(g.y));
            o.z = cvt_pk_bf16((s[4] * ic - bf_lo(me.z)) * bf_lo(g.z), (s[5] * ic - bf_hi(me.z)) * bf_hi(g.z)); o.w = cvt_pk_bf16((s[6] * ic - bf_lo(me.w)) * bf_lo(g.w), (s[7] * ic - bf_hi(me.w)) * bf_hi(g.w));
            *(u32x4*)(p + (size_t)(tokb + tt) * DI + c8) = o;
        }
    }
}
__device__ __forceinline__ void pool_phase(const Ctx& C, const bf16_t* xc, const bf16_t* sg, bf16_t* p) {
    const int c8 = C.tid * 8; const int grp = C.wave >> 1;
    for (int blk = C.bid; blk < MTOK / 64; blk += C.G) {
        if (grp == 0) pool_rows<2, 8>(xc, sg, p, blk * 64, 64, c8);
        else if (grp == 1) pool_rows<4, 4>(xc, sg, p, blk * 64, 64, c8);
        else if (grp == 2) pool_rows<8, 4>(xc, sg, p, blk * 64, 64, c8);
        else pool_rows<16, 2>(xc, sg, p, blk * 64, 64, c8);
    }
}

__device__ __forceinline__ void grid_bar(unsigned* base, unsigned gen, unsigned G) {
    asm volatile("s_waitcnt vmcnt(0) lgkmcnt(0)" ::: "memory");
    __syncthreads();
    if (threadIdx.x == 0) {
        __builtin_amdgcn_fence(__ATOMIC_RELEASE, "agent");
        asm volatile("s_waitcnt vmcnt(0)" ::: "memory");
        unsigned* flag = base + 64 * (1 + (blockIdx.x >> 4));
        (void)__hip_atomic_fetch_add(base, 1u, __ATOMIC_RELAXED, __HIP_MEMORY_SCOPE_AGENT);
        if ((blockIdx.x & 15u) == 0u) {
            while (__hip_atomic_load(base, __ATOMIC_RELAXED, __HIP_MEMORY_SCOPE_AGENT) < gen * G) __builtin_amdgcn_s_sleep(1);
            __hip_atomic_store(flag, gen, __ATOMIC_RELAXED, __HIP_MEMORY_SCOPE_AGENT);
        } else {
            while (__hip_atomic_load(flag, __ATOMIC_RELAXED, __HIP_MEMORY_SCOPE_AGENT) < gen) __builtin_amdgcn_s_sleep(1);
        }
        __builtin_amdgcn_fence(__ATOMIC_ACQUIRE, "agent");
        asm volatile("s_waitcnt vmcnt(0)" ::: "memory");
    }
    __syncthreads();
}

struct Args { const float* in[17]; float* out; unsigned char* ws; int ph_lo, ph_hi; };

#define PHASE_BEGIN if (ph >= lo && ph < hi) { \
        unsigned char* ws = args.ws; asm volatile("" : "+s"(ws)); int tid_ = threadIdx.x; asm volatile("" : "+v"(tid_)); \
        Ctx C; C.tid = tid_; C.lane = tid_ & 63; C.wave = __builtin_amdgcn_readfirstlane(tid_ >> 6); C.G = gridDim.x; C.bid = blockIdx.x; C.lds = lds_raw; \
        LAS unsigned char* ldsl = (LAS unsigned char*)lds_raw; (void)ldsl; (void)ws;
#define PHASE_END   if (ph + 1 < hi) { if (ph == 0) grid.sync(); else { ++nbar; grid_bar((unsigned*)(args.ws + WS_BAR), nbar, gridDim.x); } } } ++ph;
#define WSP(T, off) ((T*)(ws + (off)))

#define GEMM_OUT(TBUF, XCUR) PHASE_BEGIN { \
        pg8::Sched S{64, 8, 64 * 8, C.G, C.bid, 1, WSP(bf16_t, TBUF), WSP(bf16_t, WS_WOUT), 0, 0, (size_t)256 * DI, 0, 0, (size_t)256 * DI}; \
        EpiOut E{XCUR, args.out}; \
        pg8::gemm_phase<EpiOut>(ldsl, C.tid, DI, DI, DI, S, E); } PHASE_END

#define LAYER_A(J, XCUR, FIRST) \
    PHASE_BEGIN REP(2) { int base = 0; \
        conv_mat(C, args.in[2] + (size_t)(J) * DM * 3 * DI, 3 * DI, DM, 3 * DI, WSP(bf16_t, WS_WIN), 1, base); \
        conv_mat(C, args.in[6] + (size_t)(J) * DI * DM, DM, DI, DM, WSP(bf16_t, WS_WOUT), 0, base); \
        if (FIRST) gen_tables(C, WSP(bf16_t, WS_CS), WSP(bf16_t, WS_M1), WSP(bf16_t, WS_M2)); \
        norm_phase(C, XCUR, args.in[1] + (size_t)(J) * DM, WSP(bf16_t, WS_RB)); } PHASE_END \
    PHASE_BEGIN REP(8) { \
        pg8::Sched S{64, 48, 64 * 48, C.G, C.bid, 1, WSP(bf16_t, WS_RB), WSP(bf16_t, WS_WIN), 0, 0, (size_t)256 * DM, 0, 0, (size_t)256 * DM}; \
        EpiA1 E{WSP(bf16_t, WS_RC), WSP(bf16_t, WS_RD), WSP(float, WS_SS)}; \
        pg8::gemm_phase<EpiA1>(ldsl, C.tid, DM, DM, DM, S, E); } PHASE_END \
    PHASE_BEGIN REP(1) { \
        mixA_phase(C, WSP(bf16_t, WS_RC), WSP(bf16_t, WS_RD), WSP(float, WS_SS), args.in[4] + (size_t)(J) * 8 * 128 * 128, args.in[5] + (size_t)(J) * 8 * 128, args.in[3] + (size_t)(J) * DI, WSP(bf16_t, WS_RE)); } PHASE_END \
    GEMM_OUT(WS_RE, XCUR)

#define LAYER_B(XCUR) \
    PHASE_BEGIN REP(2) { int base = 0; \
        conv_mat(C, args.in[8], 2 * DI, DM, 2 * DI, WSP(bf16_t, WS_WIN), 0, base); \
        conv_mat(C, args.in[10], DM, DI, DM, WSP(bf16_t, WS_WOUT), 0, base); \
        for (int g = 0; g < 8; ++g) conv_mat(C, args.in[9] + (size_t)g * 512 * 512, 512, 512, 512, WSP(bf16_t, WS_WMTB) + (size_t)g * 512 * 512, 0, base); \
        norm_phase(C, XCUR, args.in[7], WSP(bf16_t, WS_RB)); } PHASE_END \
    PHASE_BEGIN { \
        pg8::Sched S{2, 4, 8 * 2 * 4, C.G, C.bid, 1, WSP(bf16_t, WS_WMTB), WSP(bf16_t, WS_CS), (size_t)512 * 512, 0, (size_t)256 * 512, 0, 0, (size_t)256 * 512}; \
        EpiPre E{WSP(bf16_t, WS_WMIX)}; \
        pg8::gemm_phase<EpiPre>(ldsl, C.tid, 512, 512, 512, S, E); } \
        if (ph + 1 < hi) {   } } ++ph; \
    PHASE_BEGIN { \
        pg8::Sched S{64, 32, 64 * 32, C.G, C.bid, 1, WSP(bf16_t, WS_RB), WSP(bf16_t, WS_WIN), 0, 0, (size_t)256 * DM, 0, 0, (size_t)256 * DM}; \
        EpiBC1 E{WSP(bf16_t, WS_RC), WSP(bf16_t, WS_RA)}; \
        pg8::gemm_phase<EpiBC1>(ldsl, C.tid, DM, DM, DM, S, E); } PHASE_END \
    PHASE_BEGIN REP(4) { fft1_phase(C, WSP(bf16_t, WS_RC), WSP(bf16_t, WS_M1), WSP(bf16_t, WS_RD)); } PHASE_END \
    PHASE_BEGIN REP(4) { fft2_phase(C, WSP(bf16_t, WS_RD), WSP(bf16_t, WS_M2), WSP(bf16_t, WS_RB)); } PHASE_END \
    PHASE_BEGIN REP(32) { \
        pg8::Sched S{64, 2, 8 * 64 * 2, C.G, C.bid, 1, WSP(bf16_t, WS_RB), WSP(bf16_t, WS_WMIX), 1024, 0, (size_t)256 * 8192, (size_t)512 * 1024, 0, (size_t)256 * 1024}; \
        EpiGate E{WSP(bf16_t, WS_RD), WSP(bf16_t, WS_RA), nullptr, 6.9053396600248786e-4f, 0, 512}; \
        pg8::gemm_phase<EpiGate>(ldsl, C.tid, 1024, 8192, 1024, S, E); } PHASE_END \
    GEMM_OUT(WS_RD, XCUR)

#define LAYER_C(XCUR) \
    PHASE_BEGIN REP(2) { int base = 0; \
        conv_mat(C, args.in[12] + DI, 2 * DI, DM, DI, WSP(bf16_t, WS_WIN) + (size_t)DI * DM, 0, base); \
        copy_cvt(C, args.in[12], 2 * DI, DM, DI, WSP(bf16_t, WS_WIN) + (size_t)2 * DI * DM); \
        conv_mat(C, args.in[15], DM, DI, DM, WSP(bf16_t, WS_WOUT), 0, base); \
        for (int g = 0; g < 4; ++g) conv_mat(C, args.in[13] + (size_t)g * 1024 * 1024, 1024, 1024, 1024, WSP(bf16_t, WS_WMIX) + (size_t)g * 1024 * 1024, 0, base); \
        norm_phase(C, XCUR, args.in[11], WSP(bf16_t, WS_RB)); } PHASE_END \
    PHASE_BEGIN {   \
        pg8::Sched S{4, 8, 4 * 4 * 8, C.G, C.bid, 1, WSP(bf16_t, WS_WMIX), WSP(bf16_t, WS_WIN) + (size_t)2 * DI * DM, (size_t)1024 * 1024, 0, (size_t)256 * 1024, 1024, 0, (size_t)256 * DI}; \
        EpiW E{WSP(bf16_t, WS_WIN), args.in[14]}; \
        pg8::gemm_phase<EpiW>(ldsl, C.tid, 1024, 1024, DI, S, E); } PHASE_END \
    PHASE_BEGIN REP(16) { \
        pg8::Sched S{64, 32, 64 * 32, C.G, C.bid, 1, WSP(bf16_t, WS_RB), WSP(bf16_t, WS_WIN), 0, 0, (size_t)256 * DM, 0, 0, (size_t)256 * DM}; \
        EpiBC1 E{WSP(bf16_t, WS_RC), WSP(bf16_t, WS_RA)}; \
        pg8::gemm_phase<EpiBC1>(ldsl, C.tid, DM, DM, DM, S, E); } PHASE_END \
    PHASE_BEGIN REP(128) { pool_phase(C, WSP(bf16_t, WS_RC), WSP(bf16_t, WS_RA), WSP(bf16_t, WS_RE)); } PHASE_END \
    GEMM_OUT(WS_RE, XCUR)

__global__ void __launch_bounds__(NTHR, 2) fwd_mega(Args args) {
    extern __shared__ __attribute__((aligned(16))) unsigned char lds_raw[];
    cg::grid_group grid = cg::this_grid();
    int ph = 0; unsigned nbar = 0;
    const int lo = args.ph_lo, hi = args.ph_hi;
    if (blockIdx.x == 0 && threadIdx.x < 64) __hip_atomic_store((unsigned*)(args.ws + WS_BAR) + 64 * threadIdx.x, 0u, __ATOMIC_RELAXED, __HIP_MEMORY_SCOPE_AGENT);
    LAYER_A(0, args.in[0], true)
#if RUN_B
    LAYER_B(args.out)
#endif
#if RUN_C
    LAYER_C(args.out)
#endif
#if RUN_A2
    LAYER_A(1, args.out, false)
#endif
    PHASE_BEGIN { final_norm_phase(C, args.out, args.in[16]); } PHASE_END
}

extern "C" void kernel_launch(void* const* d_in, const int* in_sizes, int n_in, void* d_out, int out_size, void* d_ws, size_t ws_size, hipStream_t stream) {
    static int grid = 0;
    if (grid == 0) {
        if (n_in != 17 || ws_size < WS_END) { fprintf(stderr, "kernel_launch: unexpected n_in %d / ws_size %zu (need %zu)\n", n_in, ws_size, (size_t)WS_END); grid = -1; return; }
        int dev = 0, cus = 0, per_cu = 0;
        hipGetDevice(&dev); hipDeviceGetAttribute(&cus, hipDeviceAttributeMultiprocessorCount, dev);
        if (hipFuncSetAttribute((const void*)fwd_mega, hipFuncAttributeMaxDynamicSharedMemorySize, LDS_BYTES) != hipSuccess) { fprintf(stderr, "kernel_launch: hipFuncSetAttribute failed\n"); grid = -1; return; }
        if (hipOccupancyMaxActiveBlocksPerMultiprocessor(&per_cu, (const void*)fwd_mega, NTHR, LDS_BYTES) != hipSuccess || per_cu < 1) { fprintf(stderr, "kernel_launch: occupancy query says %d\n", per_cu); per_cu = 1; }
        (void)hipGetLastError();
        grid = cus;
        fprintf(stderr, "kernel_launch: grid %d (per_cu %d), ws %zu\n", grid, per_cu, ws_size);
    }
    if (grid < 0) return;
    Args a{};
    for (int i = 0; i < 17; ++i) a.in[i] = (const float*)d_in[i];
    a.out = (float*)d_out; a.ws = (unsigned char*)d_ws;
    hipError_t e = hipSuccess;
#if MULTI_LAUNCH
    for (int p = 0; p < 20 && e == hipSuccess; ++p) { a.ph_lo = p; a.ph_hi = p + 1; void* kargs[] = {&a};
        e = hipLaunchCooperativeKernel((const void*)fwd_mega, dim3(grid), dim3(NTHR), kargs, LDS_BYTES, stream); }
#else
    a.ph_lo = 0; a.ph_hi = 1000;
    void* kargs[] = {&a};
    e = hipLaunchCooperativeKernel((const void*)fwd_mega, dim3(grid), dim3(NTHR), kargs, LDS_BYTES, stream);
#endif
    if (e != hipSuccess) fprintf(stderr, "kernel_launch: cooperative launch failed: %s\n", hipGetErrorString(e));
}
```
